# Optimizing an MI355X kernel written in HIP

```python
import math
import jax, jax.numpy as jnp
from jax import lax
import numpy as np

D_MODEL = 1024
BATCH = 16
SEQ = 2048
DEPTH = 1

HEAD_DIM = 64
N_ATTN_HEADS = 8
N_HGRN_HEADS = 8
ATTN_WIDTH = N_ATTN_HEADS * HEAD_DIM
HGRN_WIDTH = N_HGRN_HEADS * HEAD_DIM
MIX_WIDTH = ATTN_WIDTH + HGRN_WIDTH
IN_PROJ_WIDTH = 3 * ATTN_WIDTH + 4 * HGRN_WIDTH
DILATED_CONFIGS = ((128, 1), (512, 4), (2048, 16))
ATTN_BLOCK = 128
HGRN_CHUNK = 32
N_GROUPS = 4
EXPERTS_PER_GROUP = 8
N_EXPERTS = N_GROUPS * EXPERTS_PER_GROUP
EXPERT_TOP_K = 2
D_EXPERT = 512
MOE_BLOCK = 128
EPS = 1e-6

kernel_name = "hybrid_dilated_attn_hgrn2_hmoe"


def rmsnorm(x, g):
    xf = x.astype(jnp.float32)
    y = xf * lax.rsqrt(jnp.mean(xf * xf, axis=-1, keepdims=True) + EPS)
    return (y * g.astype(jnp.float32)).astype(x.dtype)


def alibi_slopes(n_heads):
    return 2.0 ** (-8.0 * jnp.arange(1, n_heads + 1, dtype=jnp.float32) / n_heads)


def dilated_branch(q, k, v, slopes, window, dilation):
    B, S, H, Dh = q.shape
    n_keys = window // dilation
    assert n_keys <= ATTN_BLOCK
    U = S // dilation
    nb = -(-U // ATTN_BLOCK)
    Up = nb * ATTN_BLOCK

    def to_blocks(t):
        t = t.reshape(B, U, dilation, H, Dh).transpose(0, 2, 1, 3, 4)
        t = jnp.pad(t, ((0, 0), (0, 0), (0, Up - U), (0, 0), (0, 0)))
        return t.reshape(B, dilation, nb, ATTN_BLOCK, H, Dh)

    def from_blocks(t):
        rest = t.shape[4:]
        t = t.reshape((B, dilation, Up) + rest)[:, :, :U]
        return jnp.swapaxes(t, 1, 2).reshape((B, S) + rest)

    def with_prev(t):
        prev = jnp.pad(t, ((0, 0), (0, 0), (1, 0), (0, 0), (0, 0), (0, 0)))[:, :, :-1]
        return jnp.concatenate([prev, t], axis=3)

    qb = to_blocks(q)
    kk = with_prev(to_blocks(k))
    vv = with_prev(to_blocks(v))
    scores = jnp.einsum('bgnqhd,bgnkhd->bgnhqk', qb, kk,
                        preferred_element_type=jnp.float32) / math.sqrt(Dh)
    qi = jnp.arange(ATTN_BLOCK)[:, None]
    ki = jnp.arange(2 * ATTN_BLOCK)[None, :]
    sub_dist = qi + ATTN_BLOCK - ki
    band = (sub_dist >= 0) & (sub_dist <= n_keys)
    key_pos = jnp.arange(nb)[:, None, None] * ATTN_BLOCK + ki[None] - ATTN_BLOCK
    valid = band[None] & (key_pos >= 0)
    bias = -slopes[:, None, None] * (sub_dist * dilation).astype(jnp.float32)[None]
    scores = jnp.where(valid[None, None, :, None], scores + bias[None, None, None], -jnp.inf)
    lse = jax.nn.logsumexp(scores, axis=-1)
    p = jnp.exp(scores - lse[..., None])
    o = jnp.einsum('bgnhqk,bgnkhd->bgnqhd', p, vv.astype(jnp.float32))
    return from_blocks(o), from_blocks(jnp.swapaxes(lse, -1, -2))


def dilated_attention(q, k, v):
    slopes = alibi_slopes(q.shape[2])
    outs, lses = [], []
    for window, dilation in DILATED_CONFIGS:
        o_c, lse_c = dilated_branch(q, k, v, slopes, window, dilation)
        outs.append(o_c)
        lses.append(lse_c)
    w = jax.nn.softmax(jnp.stack(lses, axis=0), axis=0)
    return jnp.sum(w[..., None] * jnp.stack(outs, axis=0), axis=0)


def hgrn2(q, f_raw, i_in, lb):
    B, S, H, Dk = q.shape
    Dv = i_in.shape[-1]
    C = HGRN_CHUNK
    nC = S // C
    f32 = jnp.float32
    q, f_raw, i_in = q.astype(f32), f_raw.astype(f32), i_in.astype(f32)
    lb = lb.reshape(H, Dk)
    log_f = jnp.log(lb + (1.0 - lb) * jax.nn.sigmoid(f_raw))
    key = (1.0 - lb) * jax.nn.sigmoid(-f_raw)
    q = jax.nn.silu(q)
    rs = lambda t: t.reshape(B, nC, C, H, t.shape[-1])
    qc, kc, vc, lfc = rs(q), rs(key), rs(i_in), rs(log_f)
    b = jnp.cumsum(lfc, axis=2)
    b_last = b[:, :, -1:]
    q_in = qc * jnp.exp(b)
    k_in = kc * jnp.exp(-b)
    k_end = kc * jnp.exp(b_last - b)
    causal = jnp.tril(jnp.ones((C, C), dtype=bool))
    A = jnp.where(causal, jnp.einsum('bnthk,bnshk->bnhts', q_in, k_in), 0.0)
    o_intra = jnp.einsum('bnhts,bnshv->bnthv', A, vc)
    dS = jnp.einsum('bnshk,bnshv->bnhkv', k_end, vc)
    decay = jnp.exp(b_last[:, :, 0])

    def step(S_prev, inp):
        dec, ds = inp
        return dec[..., None] * S_prev + ds, S_prev

    S0 = jnp.zeros((B, H, Dk, Dv), f32)
    _, S_prevs = lax.scan(step, S0, (jnp.swapaxes(decay, 0, 1), jnp.swapaxes(dS, 0, 1)))
    S_prevs = jnp.swapaxes(S_prevs, 0, 1)
    o_inter = jnp.einsum('bnthk,bnhkv->bnthv', q_in, S_prevs)
    return (o_intra + o_inter).reshape(B, S, H, Dv)


def hier_moe(h, w_group, b_group, w_router, b_router, w_gate, w_up, w_down):
    B, S, D = h.shape
    N = B * S
    f32 = jnp.float32
    xf = h.reshape(N, D)
    grp_logits = (xf @ w_group).astype(f32) + b_group.astype(f32)
    p_grp = jax.nn.softmax(grp_logits, axis=-1)
    g_sel = jnp.argmax(grp_logits, axis=-1).astype(jnp.int32)
    w_g = jnp.take_along_axis(p_grp, g_sel[:, None], axis=1)
    exp_logits = ((xf @ w_router).astype(f32) + b_router.astype(f32)).reshape(N, N_GROUPS, EXPERTS_PER_GROUP)
    sel_logits = jnp.take_along_axis(exp_logits, g_sel[:, None, None], axis=1)[:, 0]
    top_vals, top_idx = lax.top_k(sel_logits, EXPERT_TOP_K)
    gate = w_g * jax.nn.softmax(top_vals, axis=-1)
    eid = (g_sel[:, None] * EXPERTS_PER_GROUP + top_idx).reshape(-1).astype(jnp.int32)
    tok = jnp.repeat(jnp.arange(N, dtype=jnp.int32), EXPERT_TOP_K)
    A_n = N * EXPERT_TOP_K
    order = jnp.argsort(eid)
    eid_s, tok_s, gate_s = eid[order], tok[order], gate.reshape(-1)[order]
    counts = jnp.bincount(eid, length=N_EXPERTS).astype(jnp.int32)
    starts = jnp.cumsum(counts) - counts
    padded = ((counts + MOE_BLOCK - 1) // MOE_BLOCK) * MOE_BLOCK
    pad_ends = jnp.cumsum(padded)
    pad_starts = pad_ends - padded
    dest = pad_starts[eid_s] + jnp.arange(A_n, dtype=jnp.int32) - starts[eid_s]
    P = (-(-A_n // MOE_BLOCK)) * MOE_BLOCK + N_EXPERTS * MOE_BLOCK
    n_blocks = P // MOE_BLOCK
    buf_tok = jnp.full((P,), N, jnp.int32).at[dest].set(tok_s)
    buf_gate = jnp.zeros((P,), f32).at[dest].set(gate_s)
    block_expert = jnp.minimum(
        jnp.searchsorted(pad_ends, jnp.arange(n_blocks, dtype=jnp.int32) * MOE_BLOCK, side='right'),
        N_EXPERTS - 1).astype(jnp.int32)
    x_pad = jnp.concatenate([xf, jnp.zeros((1, D), xf.dtype)], axis=0)

    def run_block(args):
        e, toks, gts = args
        xb = x_pad[toks]
        hid = jax.nn.silu(xb @ w_gate[e]) * (xb @ w_up[e])
        return ((hid @ w_down[e]) * gts[:, None].astype(xb.dtype)).astype(h.dtype)

    y = lax.map(run_block, (block_expert, buf_tok.reshape(n_blocks, MOE_BLOCK),
                            buf_gate.reshape(n_blocks, MOE_BLOCK)))
    out = jnp.zeros((N + 1, D), h.dtype).at[buf_tok].add(y.reshape(P, D))[:N]
    return out.reshape(B, S, D)


def setup_inputs(seed: int = 0) -> dict:
    key = jax.random.key(seed)
    ks = jax.random.split(key, 16)
    f32 = jnp.float32
    nrm = lambda k, shape, scale: jax.random.normal(k, shape, f32) * scale
    L = DEPTH
    return {
        "x": jax.random.normal(ks[0], (BATCH, SEQ, D_MODEL), f32),
        "norm1_g": 1.0 + nrm(ks[1], (L, D_MODEL), 0.05),
        "w_in": nrm(ks[2], (L, D_MODEL, IN_PROJ_WIDTH), D_MODEL ** -0.5),
        "attn_norm_g": 1.0 + nrm(ks[3], (L, ATTN_WIDTH), 0.05),
        "hgrn_gamma": nrm(ks[4], (L + 1, HGRN_WIDTH), 0.1),
        "hgrn_norm_g": 1.0 + nrm(ks[5], (L, HGRN_WIDTH), 0.05),
        "w_out": nrm(ks[6], (L, MIX_WIDTH, D_MODEL), MIX_WIDTH ** -0.5),
        "norm2_g": 1.0 + nrm(ks[7], (L, D_MODEL), 0.05),
        "w_group": nrm(ks[8], (L, D_MODEL, N_GROUPS), D_MODEL ** -0.5),
        "b_group": nrm(ks[9], (L, N_GROUPS), 0.01),
        "w_router": nrm(ks[10], (L, D_MODEL, N_EXPERTS), D_MODEL ** -0.5),
        "b_router": nrm(ks[11], (L, N_EXPERTS), 0.01),
        "w_gate": nrm(ks[12], (L, N_EXPERTS, D_MODEL, D_EXPERT), D_MODEL ** -0.5),
        "w_up": nrm(ks[13], (L, N_EXPERTS, D_MODEL, D_EXPERT), D_MODEL ** -0.5),
        "w_down": nrm(ks[14], (L, N_EXPERTS, D_EXPERT, D_MODEL), D_EXPERT ** -0.5),
        "norm_f_g": 1.0 + nrm(ks[15], (D_MODEL,), 0.05),
    }


def reference(x, norm1_g, w_in, attn_norm_g, hgrn_gamma, hgrn_norm_g, w_out, norm2_g,
              w_group, b_group, w_router, b_router, w_gate, w_up, w_down, norm_f_g):
    B, S, _ = x.shape
    split_at = [ATTN_WIDTH, 2 * ATTN_WIDTH, 3 * ATTN_WIDTH,
                3 * ATTN_WIDTH + HGRN_WIDTH, 3 * ATTN_WIDTH + 2 * HGRN_WIDTH,
                3 * ATTN_WIDTH + 3 * HGRN_WIDTH]
    lower_bounds = jnp.cumsum(jax.nn.softmax(hgrn_gamma.astype(jnp.float32), axis=0), axis=0)
    for layer in range(DEPTH):
        h = rmsnorm(x, norm1_g[layer])
        proj = h @ w_in[layer]
        qa, ka, va, qh, fh, ih, gh = jnp.split(proj, split_at, axis=-1)
        heads = lambda t, n: t.reshape(B, S, n, HEAD_DIM)
        o_attn = dilated_attention(heads(qa, N_ATTN_HEADS), heads(ka, N_ATTN_HEADS),
                                   heads(va, N_ATTN_HEADS)).reshape(B, S, ATTN_WIDTH)
        y_attn = rmsnorm(o_attn, attn_norm_g[layer])
        o_h = hgrn2(heads(qh, N_HGRN_HEADS), heads(fh, N_HGRN_HEADS), heads(ih, N_HGRN_HEADS),
                    lower_bounds[layer])
        o_h = rmsnorm(o_h, hgrn_norm_g[layer].reshape(N_HGRN_HEADS, HEAD_DIM)).reshape(B, S, HGRN_WIDTH)
        y_hgrn = o_h * jax.nn.silu(gh.astype(jnp.float32))
        mixed = jnp.concatenate([y_attn, y_hgrn], axis=-1).astype(x.dtype)
        x = x + mixed @ w_out[layer]
        h2 = rmsnorm(x, norm2_g[layer])
        x = x + hier_moe(h2, w_group[layer], b_group[layer], w_router[layer], b_router[layer],
                         w_gate[layer], w_up[layer], w_down[layer])
    return rmsnorm(x, norm_f_g)
```

```cpp
#include <hip/hip_runtime.h>
#include <cstdio>
#include <cstdint>

#ifndef PROBE_DUP
#define PROBE_DUP -1
#endif
#ifndef MK_FUSED
#define MK_FUSED 1
#endif

#define GAS __attribute__((address_space(1)))
#define LAS __attribute__((address_space(3)))
typedef unsigned short bf16;
typedef unsigned short bf16_t;
typedef short bf16x8 __attribute__((ext_vector_type(8)));
typedef float f32x4 __attribute__((ext_vector_type(4)));
typedef float f32x2 __attribute__((ext_vector_type(2)));
typedef unsigned u32x4 __attribute__((ext_vector_type(4)));
typedef unsigned u32x2 __attribute__((ext_vector_type(2)));
typedef GAS unsigned gu32;

constexpr int NWAVES = 8, NTHR = 512;
constexpr int NTOK = 32768, DM = 1024, SEQ = 2048, NBATCH = 16, NH = 8, HD = 64;
constexpr int NPROJ = 3584;
constexpr int PPITCH = 3712;
constexpr int POPITCH = 640;
constexpr int C_Q = 0, C_K = 512, C_V = 1024, C_HQ = 1536, C_HF = 2048, C_HI = 2560, C_HG = 3072;
constexpr int NEXP = 32, DEXP = 512, LISTCAP = 32768;
constexpr int MAXMT = 288, PROWS = MAXMT * 256;
constexpr float EPS = 1e-6f;
constexpr float LOG2E = 1.4426950408889634f;
constexpr float QSCALE = 0.125f * LOG2E;

constexpr size_t MiB = 1u << 20;
constexpr size_t WS_CTL = 0, CTL_ZERO_BYTES = 1 * MiB;
constexpr size_t WS_TOKL = 1 * MiB;
constexpr size_t WS_GATEL = 5 * MiB;
constexpr size_t WS_SLOT = 9 * MiB;
constexpr size_t WS_SUMSQ = 10 * MiB;
constexpr size_t WS_WRT = 11 * MiB;
constexpr size_t WS_WIN = 16 * MiB;
constexpr size_t WS_WOUT = 24 * MiB;
constexpr size_t WS_WGU = 32 * MiB;
constexpr size_t WS_WD = 96 * MiB;
constexpr size_t WS_H = 128 * MiB;
constexpr size_t WS_MIX = 192 * MiB;
constexpr size_t WS_PROJ = 256 * MiB;
constexpr size_t WS_HID = 256 * MiB;
constexpr size_t WS_Y = 328 * MiB;
constexpr size_t WS_END = 488 * MiB;
constexpr int CW_TMO = 0;
constexpr int CW_BAR = 4096;
constexpr int CW_CNT = 16384;
constexpr size_t WS_SSP = 12 * MiB;

constexpr int RING_BYTES = 131072;
constexpr int LDS_PHASE = 151552;
constexpr int LDS_TAB = LDS_PHASE;
constexpr int LDS_PRE = LDS_PHASE + 4096 + 1024;
constexpr int LDS_MISC = LDS_PHASE + 4096;
constexpr int LDS_WSCR = LDS_PHASE + 5120;
constexpr int LDS_BYTES = 163840;

__device__ __forceinline__ float bf2f(unsigned short u) { return __uint_as_float((unsigned)u << 16); }
__device__ __forceinline__ float bflo(unsigned u) { return __uint_as_float(u << 16); }
__device__ __forceinline__ float bfhi(unsigned u) { return __uint_as_float(u & 0xffff0000u); }
__device__ __forceinline__ unsigned f2bf(float f) { unsigned u = __builtin_bit_cast(unsigned, f); return (u + 0x7fffu + ((u >> 16) & 1u)) >> 16; }
__device__ __forceinline__ unsigned pk2(float lo, float hi) { return f2bf(lo) | (f2bf(hi) << 16); }
__device__ __forceinline__ float wave_sum(float v) {
#pragma unroll
    for (int o = 1; o < 64; o <<= 1) v += __shfl_xor(v, o);
    return v;
}
__device__ __forceinline__ float wave_max(float v) {
#pragma unroll
    for (int o = 1; o < 64; o <<= 1) v = fmaxf(v, __shfl_xor(v, o));
    return v;
}
#define LDS_WAIT() asm volatile("s_waitcnt lgkmcnt(0)" ::: "memory")
#define VM_WAIT() asm volatile("s_waitcnt vmcnt(0)" ::: "memory")

namespace pg8 {
#define PG8_LAS __attribute__((address_space(3)))
constexpr int BM = 256, BK = 64, HALF = 128, HTB = HALF * BK * 2, STAGE_BYTES = 8 * HTB, NXCD = 8, WGM = 8;
__host__ __device__ __forceinline__ int lds_byte(int r, int c) { const int st = (r >> 4) * 2 + (c >> 5), rr = r & 15, cc = c & 31, ob = rr * 64 + cc * 2; return st * 1024 + (ob ^ (((ob >> 9) & 1) << 5)); }
__host__ __device__ __forceinline__ void stage_rc(int b, int& R, int& C) { const int st = b / 1024, sb = b % 1024, swz = sb ^ (((sb >> 9) & 1) << 5); R = (st >> 1) * 16 + swz / 64; C = (st & 1) * 32 + (swz % 64) / 2; }
__host__ __device__ __forceinline__ int perm32(int rho) { const int n = rho >> 4, i = rho & 15; return 8 * (i >> 2) + 4 * n + (i & 3); }

struct Unit { int pm, pn, e, l0, cnt, mh; };

__device__ __forceinline__ unsigned cvt_pk_bf16(float lo, float hi) { unsigned r; asm volatile("v_cvt_pk_bf16_f32 %0, %1, %2" : "=v"(r) : "v"(lo), "v"(hi)); return r; }

struct PlainSched {
    int nM, nN, nwg, G, c, K; const char* Bt;
    __device__ void init(int M, int N, int K_, int G_, int c_, const void* Bt_) { nM = M / BM; nN = N / BM; nwg = nM * nN; G = G_; c = c_; K = K_; Bt = (const char*)Bt_; }
    __device__ __forceinline__ bool next(int i, Unit& u) const {
        const long L = (long)i * G + c; if (L >= nwg) return false;
        int wgid = (int)L; { const int q = nwg / NXCD, r = nwg % NXCD, xcd = wgid % NXCD, off = wgid / NXCD; wgid = (xcd < r ? xcd * (q + 1) : r * (q + 1) + (xcd - r) * q) + off; }
        const int nig = WGM * nN, gid = wgid / nig, fm = gid * WGM, gsz = (nM - fm) < WGM ? (nM - fm) : WGM;
        u.pm = fm + ((wgid % nig) % gsz); u.pn = (wgid % nig) / gsz; u.e = 0; u.l0 = 0; u.cnt = 256; u.mh = -1; return true;
    }
    __device__ __forceinline__ int a_row(const Unit& u, int r) const { return u.pm * BM + r; }
    __device__ __forceinline__ unsigned a_off2(const Unit&, int, int row) const { return (unsigned)row * (unsigned)(K * 2); }
    __device__ __forceinline__ const char* b_ptr(const Unit& u) const { return Bt + (size_t)u.pn * BM * K * 2; }
};
template <bool GATHER> struct MoeSched {
    int G, c, T, K; const PG8_LAS int* tab; const int* tokl; const char* W; size_t wexp;
    __device__ __forceinline__ bool next(int i, Unit& u) const {
        int mt, pn, mh = -1;
        if (G == 256) { const int R = T >> 6, rem = T & 63;
            if (i == R && rem <= 32) { const int m = c >> 3, sub = c & 7; if (m >= rem) return false; mt = 64 * R + m; pn = sub >> 1; mh = sub & 1; }
            else { const int x = c & 7, j = c >> 3; mt = i * 64 + x * 8 + (j >> 2); pn = j & 3; } }
        else { const int L = i * G + c; mt = L >> 2; pn = L & 3; }
        if (mt >= T) return false;
        int l0 = tab[3 * mt + 1], cnt = tab[3 * mt + 2];
        if (mh >= 0) { if (mh) { l0 += HALF; cnt -= HALF; } else cnt = cnt < HALF ? cnt : HALF; if (cnt <= 0) return false; }
        u.pm = mt; u.pn = pn; u.mh = mh; u.e = tab[3 * mt]; u.l0 = l0; u.cnt = cnt; return true;
    }
    __device__ __forceinline__ int a_row(const Unit& u, int r) const { if (GATHER) return tokl[u.l0 + ((r < u.cnt) ? r : 0)]; return u.pm * BM + (u.mh > 0 ? HALF : 0) + r; }
    __device__ __forceinline__ unsigned a_off2(const Unit& u, int r, int row) const { if (GATHER) return (r < u.cnt) ? (unsigned)row * (unsigned)(K * 2) : 0u; return (unsigned)row * (unsigned)(K * 2); }
    __device__ __forceinline__ const char* b_ptr(const Unit& u) const { return W + (size_t)u.e * wexp + (size_t)u.pn * BM * K * 2; }
};

struct EpiProj {
    static constexpr bool PERM = true, MIDSCALE = false, PRELOAD = true;
    bf16_t* O; int ldc; float qscale; const float* rs1; PG8_LAS float* ptab;
    __device__ __forceinline__ float pre_load(const Unit& u, int tid) const { return rs1[u.pm * BM + (tid & 255)]; }
    __device__ __forceinline__ void pre_store(float v, const Unit&, int ui, int tid) const { if (tid < 256) ptab[(ui & 1) * 256 + tid] = v; }
    __device__ __forceinline__ void operator()(const f32x4 (&acc)[2][2][4][2], const Unit& u, int wr, int wc, int fr, int fq, int ui) const {
        const int row0 = u.pm * BM + wr * 64 + fr, col0 = u.pn * BM + wc * 32 + 8 * fq;
        const float sc0 = (u.pn < 2) ? qscale : 1.f;
        float rsc[2][4];
#pragma unroll
        for (int ai = 0; ai < 2; ++ai)
#pragma unroll
            for (int m = 0; m < 4; ++m) rsc[ai][m] = ptab[(ui & 1) * 256 + wr * 64 + fr + ai * HALF + m * 16];
#pragma unroll
        for (int ai = 0; ai < 2; ++ai)
#pragma unroll
            for (int m = 0; m < 4; ++m) { bf16_t* rowp = O + (size_t)(row0 + ai * HALF + m * 16) * ldc + col0; const float sc = sc0 * rsc[ai][m];
#pragma unroll
                for (int bj = 0; bj < 2; ++bj) { const f32x4 v0 = acc[ai][bj][m][0] * sc, v1 = acc[ai][bj][m][1] * sc;
                    u32x4 w; w.x = cvt_pk_bf16(v0[0], v0[1]); w.y = cvt_pk_bf16(v0[2], v0[3]); w.z = cvt_pk_bf16(v1[0], v1[1]); w.w = cvt_pk_bf16(v1[2], v1[3]);
                    *(u32x4*)(rowp + bj * HALF) = w; } }
    }
};
struct EpiRes {
    static constexpr bool PERM = true, MIDSCALE = true, PRELOAD = false;
    const bf16_t* base; bf16_t* out; int ldc; float* ss2; const PG8_LAS float* rtab;
    __device__ __forceinline__ void midscale(f32x4 (&acc)[2][2][4][2], int ui, int wr, int fr) const {
#pragma unroll
        for (int ai = 0; ai < 2; ++ai)
#pragma unroll
            for (int m = 0; m < 4; ++m) { const float s = rtab[256 * ui + ai * HALF + wr * 64 + m * 16 + fr];
#pragma unroll
                for (int bj = 0; bj < 2; ++bj)
#pragma unroll
                    for (int n = 0; n < 2; ++n) acc[ai][bj][m][n] = acc[ai][bj][m][n] * s; }
    }
    __device__ __forceinline__ void operator()(const f32x4 (&acc)[2][2][4][2], const Unit& u, int wr, int wc, int fr, int fq) const {
        const int row0 = u.pm * BM + wr * 64 + fr, col0 = u.pn * BM + wc * 32 + 8 * fq;
        u32x4 pre[2][4][2];
#pragma unroll
        for (int ai = 0; ai < 2; ++ai)
#pragma unroll
            for (int m = 0; m < 4; ++m) { const size_t off = (size_t)(row0 + ai * HALF + m * 16) * ldc + col0;
#pragma unroll
                for (int bj = 0; bj < 2; ++bj) pre[ai][m][bj] = *(const u32x4*)(base + off + bj * HALF); }
#pragma unroll
        for (int ai = 0; ai < 2; ++ai) {
#pragma unroll
            for (int m = 0; m < 4; ++m) { const int row = row0 + ai * HALF + m * 16; const size_t off = (size_t)row * ldc + col0; float ss = 0.f;
#pragma unroll
                for (int bj = 0; bj < 2; ++bj) { const u32x4 pb_ = pre[ai][m][bj]; const f32x4 b0 = (f32x4){bflo(pb_.x), bfhi(pb_.x), bflo(pb_.y), bfhi(pb_.y)}, b1 = (f32x4){bflo(pb_.z), bfhi(pb_.z), bflo(pb_.w), bfhi(pb_.w)};
                    const f32x4 o0 = b0 + acc[ai][bj][m][0], o1 = b1 + acc[ai][bj][m][1];
                    u32x4 w; w.x = cvt_pk_bf16(o0.x, o0.y); w.y = cvt_pk_bf16(o0.z, o0.w); w.z = cvt_pk_bf16(o1.x, o1.y); w.w = cvt_pk_bf16(o1.z, o1.w);
                    *(u32x4*)(out + off + bj * HALF) = w;
                    ss += (o0.x * o0.x + o0.y * o0.y) + (o0.z * o0.z + o0.w * o0.w) + (o1.x * o1.x + o1.y * o1.y) + (o1.z * o1.z + o1.w * o1.w); }
                ss += __shfl_xor(ss, 16); ss += __shfl_xor(ss, 32);
                if (fq == 0) ss2[(size_t)(u.pn * 4 + wc) * NTOK + row] = ss; } }
    }
};
__device__ __forceinline__ float silu_f(float g) { return g * __builtin_amdgcn_rcpf(1.f + __builtin_amdgcn_exp2f(-g * LOG2E)); }
__device__ __forceinline__ unsigned pk4_fp8(float a, float b, float c, float d) { int p = 0; p = __builtin_amdgcn_cvt_pk_fp8_f32(a, b, p, false); p = __builtin_amdgcn_cvt_pk_fp8_f32(c, d, p, true); return (unsigned)p; }
struct EpiGU {
    static constexpr bool PERM = true, MIDSCALE = false, PRELOAD = false;
    unsigned char* Hd;
    __device__ __forceinline__ void operator()(const f32x4 (&acc)[2][2][4][2], const Unit& u, int wr, int wc, int fr, int fq) const {
        const int row0 = u.pm * BM + (u.mh > 0 ? HALF : 0) + wr * 64 + fr, col0 = u.pn * HALF + wc * 32 + 8 * fq;
#pragma unroll
        for (int ai = 0; ai < 2; ++ai) { if (ai == 1 && u.mh >= 0) continue;
#pragma unroll
            for (int m = 0; m < 4; ++m) { unsigned char* rowp = Hd + (size_t)(row0 + ai * HALF + m * 16) * DEXP + col0;
                const f32x4 g0 = acc[ai][0][m][0], g1 = acc[ai][0][m][1], u0 = acc[ai][1][m][0], u1 = acc[ai][1][m][1];
                u32x2 w; w.x = pk4_fp8(silu_f(g0[0]) * u0[0], silu_f(g0[1]) * u0[1], silu_f(g0[2]) * u0[2], silu_f(g0[3]) * u0[3]);
                w.y = pk4_fp8(silu_f(g1[0]) * u1[0], silu_f(g1[1]) * u1[1], silu_f(g1[2]) * u1[2], silu_f(g1[3]) * u1[3]);
                *(u32x2*)rowp = w; } }
    }
};
struct EpiDown {
    static constexpr bool PERM = true, MIDSCALE = false, PRELOAD = true;
    unsigned char* Y; const float* gatel; PG8_LAS float* ptab;
    __device__ __forceinline__ float pre_load(const Unit& u, int tid) const { const int r = tid & 255; return gatel[u.l0 + ((r < u.cnt) ? r : 0)]; }
    __device__ __forceinline__ void pre_store(float v, const Unit& u, int ui, int tid) const { if (tid < 256) ptab[(ui & 1) * 256 + tid] = (tid < u.cnt) ? 16.f * v : 0.f; }
    __device__ __forceinline__ void operator()(const f32x4 (&acc)[2][2][4][2], const Unit& u, int wr, int wc, int fr, int fq, int ui) const {
        const int r0 = wr * 64 + fr, col0 = u.pn * BM + wc * 32 + 8 * fq;
        float gts[2][4];
#pragma unroll
        for (int ai = 0; ai < 2; ++ai)
#pragma unroll
            for (int m = 0; m < 4; ++m) gts[ai][m] = ptab[(ui & 1) * 256 + r0 + ai * HALF + m * 16];
#pragma unroll
        for (int ai = 0; ai < 2; ++ai) { if (ai == 1 && u.mh >= 0) continue;
#pragma unroll
            for (int m = 0; m < 4; ++m) { const int r = r0 + ai * HALF + m * 16; const float gt = gts[ai][m];
                unsigned char* rowp = Y + (size_t)(u.pm * BM + (u.mh > 0 ? HALF : 0) + r) * DM + col0;
#pragma unroll
                for (int bj = 0; bj < 2; ++bj) { const f32x4 v0 = acc[ai][bj][m][0] * gt, v1 = acc[ai][bj][m][1] * gt;
                    u32x2 w; w.x = pk4_fp8(v0[0], v0[1], v0[2], v0[3]); w.y = pk4_fp8(v1[0], v1[1], v1[2], v1[3]);
                    *(u32x2*)(rowp + bj * HALF) = w; } } }
    }
};

typedef int v8i_t __attribute__((ext_vector_type(8)));
constexpr int FP8_SCALE_W = 0x7A7A7A7A, FP8_SCALE_X = 0x7F7F7F7F;

struct Frag16 { bf16x8 k[2]; };
__device__ __forceinline__ void ldfrag(Frag16& d, const PG8_LAS unsigned char* p) { d.k[0] = *(const PG8_LAS bf16x8*)p; d.k[1] = *(const PG8_LAS bf16x8*)(p + 1024); }
__device__ __forceinline__ void ldfrag(v8i_t& d, const PG8_LAS unsigned char* p) { typedef int v4i_t __attribute__((ext_vector_type(4))); const v4i_t lo = *(const PG8_LAS v4i_t*)p, hi = *(const PG8_LAS v4i_t*)(p + 16);
    d = __builtin_shufflevector(lo, hi, 0, 1, 2, 3, 4, 5, 6, 7); }
__device__ __forceinline__ void mmafrag(f32x4& c, const Frag16& b, const Frag16& a) { c = __builtin_amdgcn_mfma_f32_16x16x32_bf16(b.k[0], a.k[0], c, 0, 0, 0); c = __builtin_amdgcn_mfma_f32_16x16x32_bf16(b.k[1], a.k[1], c, 0, 0, 0); }
__device__ __forceinline__ void mmafrag(f32x4& c, const v8i_t& b, const v8i_t& a) {
    asm volatile("s_nop 1\n\tv_mfma_scale_f32_16x16x128_f8f6f4 %0, %1, %2, %0, %3, %4 op_sel_hi:[0,0,0]" : "+v"(c) : "v"(b), "v"(a), "v"(FP8_SCALE_W), "v"(FP8_SCALE_X)); }
template <bool FP8> struct FragT { typedef Frag16 T; };
template <> struct FragT<true> { typedef v8i_t T; };
template <class Epi, class Sched, bool ALIGN_EPI, bool FP8 = false>
__device__ __forceinline__ void gemm_phase(PG8_LAS unsigned char* lds, const void* Abase, const int K, const Sched& S, const Epi& E) {
    const int tid = threadIdx.x, wid = __builtin_amdgcn_readfirstlane(tid >> 6), lane = tid & 63, wr = wid >> 2, wc = wid & 3, fr = lane & 15, fq = lane >> 4;
    const int nt = K / BK;
    unsigned voffB[2];
#pragma unroll
    for (int i = 0; i < 2; ++i) { int R, C; stage_rc(tid * 16 + i * 8192, R, C); const int Rb = Epi::PERM ? ((R & ~31) + perm32(R & 31)) : R; voffB[i] = (unsigned)(Rb * K + C) * 2u; }
    const size_t kstep = (size_t)(BK * 2);
    const size_t hstepB = (size_t)HALF * K * 2;
    const unsigned ldsw = (unsigned)wid * 1024u;
    const int aoff = lds_byte(wr * 64 + fr, fq * (FP8 ? 16 : 8)), boff = lds_byte(wc * 32 + fr, fq * (FP8 ? 16 : 8));
#define PG8_SA(b, h) (((b) * 2 + (h)) * HTB)
#define PG8_SB(b, h) ((4 + (b) * 2 + (h)) * HTB)
#define PG8_STAGE(bufoff, gbase, voff) do { _Pragma("unroll") for (int _i = 0; _i < 2; ++_i) \
        __builtin_amdgcn_global_load_lds((const unsigned*)((const char*)(gbase) + (voff)[_i]), (PG8_LAS unsigned*)(lds + (bufoff) + ldsw + _i * 8192), 16, 0, 0); } while (0)
#define PG8_AOFF(dst, u) do { int t_[2][2]; _Pragma("unroll") for (int _i = 0; _i < 2; ++_i) { int R_, C_; stage_rc(tid * 16 + _i * 8192, R_, C_); \
        _Pragma("unroll") for (int _h = 0; _h < 2; ++_h) t_[_h][_i] = S.a_row(u, _h * HALF + R_); } \
        asm volatile("" : "+v"(t_[0][0]), "+v"(t_[0][1]), "+v"(t_[1][0]), "+v"(t_[1][1]));     \
        _Pragma("unroll") for (int _i = 0; _i < 2; ++_i) { int R_, C_; stage_rc(tid * 16 + _i * 8192, R_, C_); \
        _Pragma("unroll") for (int _h = 0; _h < 2; ++_h) dst[_h][_i] = S.a_off2(u, _h * HALF + R_, t_[_h][_i]) + (unsigned)C_ * 2u; } } while (0)
#define PG8_CAT8(lo, hi) __builtin_bit_cast(v8i_t, __builtin_shufflevector(lo, hi, 0, 1, 2, 3, 4, 5, 6, 7, 8, 9, 10, 11, 12, 13, 14, 15))
#define PG8_LDA(dst, b, h) do { _Pragma("unroll") for (int m = 0; m < 4; ++m) ldfrag(dst[m], lds + PG8_SA(b, h) + aoff + m * 2048); } while (0)
#define PG8_LDB(dst, b, h) do { _Pragma("unroll") for (int n = 0; n < 2; ++n) ldfrag(dst[n], lds + PG8_SB(b, h) + boff + n * 2048); } while (0)
#define PG8_MMA(ai, bj, At, Bt) do { __builtin_amdgcn_s_setprio(1); _Pragma("unroll") for (int m = 0; m < 4; ++m) _Pragma("unroll") for (int n = 0; n < 2; ++n) mmafrag(acc[ai][bj][m][n], Bt[n], At[m]); \
        __builtin_amdgcn_s_setprio(0); } while (0)
#define PG8_WAIT_V(n) asm volatile("s_waitcnt vmcnt(" #n ")" ::: "memory")
#define PG8_WAIT_L(n) asm volatile("s_waitcnt lgkmcnt(" #n ")" ::: "memory")
#define PG8_BAR __builtin_amdgcn_s_barrier()
#define PG8_SCHED __builtin_amdgcn_sched_barrier(0)
    Unit cur, nxt; int ui = 0;
    if (!S.next(0, cur)) return;
    f32x4 acc[2][2][4][2];
#pragma unroll
    for (int a = 0; a < 2; ++a)
#pragma unroll
        for (int b = 0; b < 2; ++b)
#pragma unroll
            for (int m = 0; m < 4; ++m)
#pragma unroll
                for (int n = 0; n < 2; ++n) acc[a][b][m][n] = (f32x4){0.f, 0.f, 0.f, 0.f};
    typename FragT<FP8>::T At[4], B0[2], B1[2];
    unsigned vC[2][2], vN[2][2];
    PG8_AOFF(vC, cur);
    const char* const Ab = (const char*)Abase;
    const char* cB = S.b_ptr(cur);
    PG8_STAGE(PG8_SB(0, 0), cB, voffB); PG8_STAGE(PG8_SB(0, 1), cB + hstepB, voffB); PG8_STAGE(PG8_SA(0, 0), Ab, vC[0]); PG8_STAGE(PG8_SA(0, 1), Ab, vC[1]);
    if (wr == 1) PG8_BAR;
    PG8_WAIT_V(2); PG8_BAR;
    PG8_STAGE(PG8_SB(1, 0), cB + kstep, voffB); PG8_STAGE(PG8_SA(1, 0), Ab + kstep, vC[0]); PG8_STAGE(PG8_SB(1, 1), cB + hstepB + kstep, voffB);
    PG8_WAIT_V(6); PG8_BAR;
    for (;;) {
        const bool has_next = S.next(ui + 1, nxt);
        const char* nB = has_next ? S.b_ptr(nxt) : cB;
        if (has_next) { PG8_AOFF(vN, nxt); }
        else {
#pragma unroll
            for (int h = 0; h < 2; ++h)
#pragma unroll
                for (int i = 0; i < 2; ++i) vN[h][i] = vC[h][i]; }
        float pre_v = 0.f; if constexpr (Epi::PRELOAD) pre_v = E.pre_load(cur, tid);
        const bool fullM = __builtin_amdgcn_readfirstlane(cur.mh) < 0;
        for (int t = 0; t < nt; t += 2) {
            if constexpr (Epi::MIDSCALE) { if (t == nt / 2) E.midscale(acc, ui, wr, fr); }
            if constexpr (Epi::PRELOAD) { if (t == nt / 2) E.pre_store(pre_v, cur, ui, tid); }
            const bool last = (t == nt - 2);
            const char* a1 = Ab + (size_t)(t + 1) * kstep;
            const char* a2 = last ? Ab : Ab + (size_t)(t + 2) * kstep; const char* b2 = last ? nB : cB + (size_t)(t + 2) * kstep;
            const char* a3 = a2 + kstep; const char* b3 = b2 + kstep;
            unsigned v2[2][2];
#pragma unroll
            for (int h = 0; h < 2; ++h)
#pragma unroll
                for (int i = 0; i < 2; ++i) v2[h][i] = last ? vN[h][i] : vC[h][i];
            PG8_LDB(B0, 0, 0); PG8_LDB(B1, 0, 1); PG8_SCHED; PG8_LDA(At, 0, 0); PG8_STAGE(PG8_SA(1, 1), a1, vC[1]);
            PG8_WAIT_V(8); PG8_WAIT_L(0); PG8_BAR; PG8_MMA(0, 0, At, B0); PG8_MMA(0, 1, At, B1); PG8_BAR; PG8_SCHED;
            if (fullM) { PG8_LDA(At, 0, 1); } PG8_STAGE(PG8_SB(0, 0), b2, voffB); PG8_STAGE(PG8_SB(0, 1), b2 + hstepB, voffB); PG8_STAGE(PG8_SA(0, 0), a2, v2[0]);
            PG8_WAIT_V(8); PG8_WAIT_L(0); PG8_BAR; if (fullM) { PG8_MMA(1, 0, At, B0); PG8_MMA(1, 1, At, B1); } PG8_BAR; PG8_SCHED;
            PG8_LDB(B0, 1, 0); PG8_LDB(B1, 1, 1); PG8_SCHED; PG8_LDA(At, 1, 0); PG8_STAGE(PG8_SA(0, 1), a2, v2[1]);
            PG8_WAIT_V(8); PG8_WAIT_L(0); PG8_BAR; PG8_MMA(0, 0, At, B0); PG8_MMA(0, 1, At, B1); PG8_BAR; PG8_SCHED;
            if (fullM) { PG8_LDA(At, 1, 1); } PG8_STAGE(PG8_SB(1, 0), b3, voffB); PG8_STAGE(PG8_SB(1, 1), b3 + hstepB, voffB); PG8_STAGE(PG8_SA(1, 0), a3, v2[0]);
            PG8_WAIT_V(8); PG8_WAIT_L(0); PG8_BAR; if (fullM) { PG8_MMA(1, 0, At, B0); PG8_MMA(1, 1, At, B1); } PG8_BAR; PG8_SCHED;
        }
        if constexpr (ALIGN_EPI) { if (wr == 0) PG8_BAR; }
        if constexpr (FP8) asm volatile("s_nop 15\n\ts_nop 15" ::: "memory");
        if constexpr (Epi::PRELOAD) E(acc, cur, wr, wc, fr, fq, ui); else E(acc, cur, wr, wc, fr, fq);
        if (!has_next) break;
#pragma unroll
        for (int a = 0; a < 2; ++a)
#pragma unroll
            for (int b = 0; b < 2; ++b)
#pragma unroll
                for (int m = 0; m < 4; ++m)
#pragma unroll
                    for (int n = 0; n < 2; ++n) acc[a][b][m][n] = (f32x4){0.f, 0.f, 0.f, 0.f};
        cur = nxt; cB = nB; ++ui;
#pragma unroll
        for (int h = 0; h < 2; ++h)
#pragma unroll
            for (int i = 0; i < 2; ++i) vC[h][i] = vN[h][i];
        if constexpr (ALIGN_EPI) { if (wr == 1) PG8_BAR; }
    }
    PG8_WAIT_V(0);
    if constexpr (!ALIGN_EPI) { if (wr == 0) PG8_BAR; }
    PG8_BAR;
#undef PG8_SA
#undef PG8_SB
#undef PG8_STAGE
#undef PG8_AOFF
#undef PG8_LDA
#undef PG8_LDB
#undef PG8_MMA
#undef PG8_CAT8
#undef PG8_WAIT_V
#undef PG8_WAIT_L
#undef PG8_BAR
#undef PG8_SCHED
}
}

#define XB_TMO      128
#define XB_XCNT(j)  (256  + 64 * (j))
#define XB_XSUB(j)  (1280 + 64 * (j))
#define XB_XGEN(j)  (2304 + 64 * (j))
#define XB_TOP      3328
#define XB_TOPGEN   3392
#define XCD_BAR_WORDS 3456
#define XB_SPIN_CAP (1u << 18)
__device__ __forceinline__ unsigned xb_ld(unsigned* p)              { return __hip_atomic_load(p, __ATOMIC_RELAXED, __HIP_MEMORY_SCOPE_AGENT); }
__device__ __forceinline__ unsigned xb_add(unsigned* p, unsigned v) { return __hip_atomic_fetch_add(p, v, __ATOMIC_RELAXED, __HIP_MEMORY_SCOPE_AGENT); }
__device__ __forceinline__ unsigned xb_xcc_id() { return (unsigned)__builtin_amdgcn_s_getreg((3 << 11) | 20) & 0xFu; }
#define XB_SPIN(cond, bar) do { unsigned _sp = 0; while (cond) { __builtin_amdgcn_s_sleep(1); \
    if ((++_sp & 255u) == 0u) { if (xb_ld(&(bar)[XB_TMO])) break; if (_sp > XB_SPIN_CAP) { atomicAdd(&(bar)[XB_TMO], 1u); break; } } } } while (0)
struct XcdBarrier { unsigned* bar; unsigned x; volatile LAS unsigned* st; };
__device__ __forceinline__ XcdBarrier xcd_barrier_post(unsigned* bar, volatile LAS unsigned* st) {
    XcdBarrier b; b.bar = bar; b.x = xb_xcc_id(); b.st = st;
    if (threadIdx.x == 0) (void)xb_add(&bar[XB_XCNT(b.x)], 1u);
    return b;
}
__device__ __forceinline__ void xcd_barrier_complete(unsigned* bar, unsigned x, unsigned& nloc, unsigned& nx) {
    const unsigned G = gridDim.x * gridDim.y * gridDim.z;
    unsigned sum, cnt, mine, sp = 0u;
    for (;;) {
        sum = 0u; cnt = 0u; mine = 0u;
#pragma unroll
        for (unsigned j = 0; j < 16; ++j) { const unsigned c = xb_ld(&bar[XB_XCNT(j)]); sum += c; cnt += (c > 0u) ? 1u : 0u; mine = (j == x) ? c : mine; }
        if (sum == G) break;
        __builtin_amdgcn_s_sleep(1);
        if ((++sp & 255u) == 0u) { if (xb_ld(&bar[XB_TMO])) break; if (sp > XB_SPIN_CAP) { atomicAdd(&bar[XB_TMO], 1u); break; } }
    }
    nloc = mine > 0u ? mine : 1u; nx = cnt > 0u ? cnt : 1u;
}
__device__ __forceinline__ void xcd_barrier(const XcdBarrier& b) {
    asm volatile("s_waitcnt vmcnt(0)" ::: "memory");
    __syncthreads();
    if (threadIdx.x == 0) {
        unsigned* bar = b.bar;
        __builtin_amdgcn_s_waitcnt(0);
        unsigned nloc = b.st[0], nx = b.st[1];
        if (nloc == 0u) { xcd_barrier_complete(bar, b.x, nloc, nx); b.st[0] = nloc; b.st[1] = nx; }
        const unsigned old = xb_add(&bar[XB_XSUB(b.x)], 1u);
        const unsigned gen = old / nloc;
        if (old + 1u == (gen + 1u) * nloc) {
            __builtin_amdgcn_fence(__ATOMIC_RELEASE, "agent");
            asm volatile("s_waitcnt vmcnt(0)" ::: "memory");
            const unsigned og = xb_add(&bar[XB_TOP], 1u);
            const unsigned tg = og / nx;
            if (og + 1u == (tg + 1u) * nx) xb_add(&bar[XB_TOPGEN], 1u);
            else XB_SPIN(xb_ld(&bar[XB_TOPGEN]) == tg, bar);
            __builtin_amdgcn_fence(__ATOMIC_ACQUIRE, "agent");
            xb_add(&bar[XB_XGEN(b.x)], 1u);
            asm volatile("s_waitcnt vmcnt(0)" ::: "memory");
        } else {
            XB_SPIN(xb_ld(&bar[XB_XGEN(b.x)]) == gen, bar);
            __builtin_amdgcn_fence(__ATOMIC_ACQUIRE, "agent");
            asm volatile("s_waitcnt vmcnt(0)" ::: "memory");
        }
    }
    __syncthreads();
}

struct Ctx {
    LAS unsigned char* lds; int tid, lane, wave, vcu, G;
    const float* in[16]; float* out; unsigned char* ws;
};

__device__ __forceinline__ void p0_transpose_item(const float* W, int K, int N, bf16* WT, int k0, int n0, int drow0, LAS float* scr, int lane, const float* kgain = nullptr) {
    const int kr = lane >> 3, c4 = lane & 7;
    f32x4 w[8];
#pragma unroll
    for (int i = 0; i < 8; ++i) w[i] = *(const f32x4*)(W + (size_t)(k0 + kr + 8 * i) * N + n0 + 4 * c4);
    if (kgain) {
#pragma unroll
        for (int i = 0; i < 8; ++i) w[i] = w[i] * kgain[k0 + kr + 8 * i]; }
#pragma unroll
    for (int i = 0; i < 8; ++i) { LAS float* d = scr + (kr + 8 * i) * 33 + 4 * c4; d[0] = w[i].x; d[1] = w[i].y; d[2] = w[i].z; d[3] = w[i].w; }
    LDS_WAIT(); asm volatile("" ::: "memory");
    const int c = lane & 7;
#pragma unroll
    for (int j = 0; j < 4; ++j) { const int n = (lane >> 3) + 8 * j; const LAS float* s = scr + (8 * c) * 33 + n;
        u32x4 o; o.x = pk2(s[0 * 33], s[1 * 33]); o.y = pk2(s[2 * 33], s[3 * 33]); o.z = pk2(s[4 * 33], s[5 * 33]); o.w = pk2(s[6 * 33], s[7 * 33]);
        *(GAS u32x4*)(WT + (size_t)(drow0 + n) * K + k0 + 8 * c) = o; }
    LDS_WAIT(); asm volatile("" ::: "memory");
}
__device__ __forceinline__ void p0_transpose_item_fp8(const float* W, int K, int N, unsigned char* WT, int k0, int n0, int drow0, LAS float* scr, int lane) {
    const int kr = lane >> 3, c4 = lane & 7;
    f32x4 w[8];
#pragma unroll
    for (int i = 0; i < 8; ++i) w[i] = *(const f32x4*)(W + (size_t)(k0 + kr + 8 * i) * N + n0 + 4 * c4);
#pragma unroll
    for (int i = 0; i < 8; ++i) { LAS float* d = scr + (kr + 8 * i) * 33 + 4 * c4; d[0] = w[i].x * 32.f; d[1] = w[i].y * 32.f; d[2] = w[i].z * 32.f; d[3] = w[i].w * 32.f; }
    LDS_WAIT(); asm volatile("" ::: "memory");
    const int q = lane & 3;
#pragma unroll
    for (int j = 0; j < 2; ++j) { const int n = (lane >> 2) + 16 * j; const LAS float* s = scr + (16 * q) * 33 + n;
        u32x4 o; o.x = pg8::pk4_fp8(s[0 * 33], s[1 * 33], s[2 * 33], s[3 * 33]); o.y = pg8::pk4_fp8(s[4 * 33], s[5 * 33], s[6 * 33], s[7 * 33]);
        o.z = pg8::pk4_fp8(s[8 * 33], s[9 * 33], s[10 * 33], s[11 * 33]); o.w = pg8::pk4_fp8(s[12 * 33], s[13 * 33], s[14 * 33], s[15 * 33]);
        *(GAS u32x4*)(WT + (size_t)(drow0 + n) * K + k0 + 16 * q) = o; }
    LDS_WAIT(); asm volatile("" ::: "memory");
}
struct ConvItem { const float* W; unsigned char* WT; int K, N, k0, n0, drow0; };
__device__ __forceinline__ ConvItem moe_conv_desc(const Ctx& F, int r) {
    unsigned char* ws = F.ws; ConvItem c; const int e = r / 768; r -= e * 768;
    if (r < 256) { const int kb = r / 16, nb = r % 16, n0 = 32 * nb; c.W = F.in[12] + (size_t)e * DM * DEXP; c.WT = (unsigned char*)(ws + WS_WGU) + (size_t)e * DM * DM; c.K = DM; c.N = DEXP; c.k0 = 64 * kb; c.n0 = n0; c.drow0 = (n0 >> 7) * 256 + (n0 & 127); return c; } r -= 256;
    if (r < 256) { const int kb = r / 16, nb = r % 16, n0 = 32 * nb; c.W = F.in[13] + (size_t)e * DM * DEXP; c.WT = (unsigned char*)(ws + WS_WGU) + (size_t)e * DM * DM; c.K = DM; c.N = DEXP; c.k0 = 64 * kb; c.n0 = n0; c.drow0 = (n0 >> 7) * 256 + 128 + (n0 & 127); return c; } r -= 256;
    { const int kb = r / 32, nb = r % 32; c.W = F.in[14] + (size_t)e * DEXP * DM; c.WT = (unsigned char*)(ws + WS_WD) + (size_t)e * DM * DEXP; c.K = DEXP; c.N = DM; c.k0 = 64 * kb; c.n0 = 32 * nb; c.drow0 = 32 * nb; return c; }
}
__device__ __forceinline__ void moe_convert_pair(const Ctx& F, int r0, int r1, LAS float* scr, int lane_in) {
    int lane = lane_in; asm volatile("" : "+v"(lane));
    const ConvItem a = moe_conv_desc(F, r0), b = moe_conv_desc(F, r1);
    const int kr = lane >> 3, c4 = lane & 7;
    f32x4 wa[8], wb[8];
#pragma unroll
    for (int i = 0; i < 8; ++i) wa[i] = *(const f32x4*)(a.W + (size_t)(a.k0 + kr + 8 * i) * a.N + a.n0 + 4 * c4);
#pragma unroll
    for (int i = 0; i < 8; ++i) wb[i] = *(const f32x4*)(b.W + (size_t)(b.k0 + kr + 8 * i) * b.N + b.n0 + 4 * c4);
#pragma unroll
    for (int half = 0; half < 2; ++half) {
        const ConvItem& c = half ? b : a;
#pragma unroll
        for (int i = 0; i < 8; ++i) { const f32x4 w = half ? wb[i] : wa[i]; LAS float* d = scr + (kr + 8 * i) * 33 + 4 * c4; d[0] = w.x * 32.f; d[1] = w.y * 32.f; d[2] = w.z * 32.f; d[3] = w.w * 32.f; }
        LDS_WAIT(); asm volatile("" ::: "memory");
        const int q = lane & 3;
#pragma unroll
        for (int j = 0; j < 2; ++j) { const int n = (lane >> 2) + 16 * j; const LAS float* s = scr + (16 * q) * 33 + n;
            u32x4 o; o.x = pg8::pk4_fp8(s[0 * 33], s[1 * 33], s[2 * 33], s[3 * 33]); o.y = pg8::pk4_fp8(s[4 * 33], s[5 * 33], s[6 * 33], s[7 * 33]);
            o.z = pg8::pk4_fp8(s[8 * 33], s[9 * 33], s[10 * 33], s[11 * 33]); o.w = pg8::pk4_fp8(s[12 * 33], s[13 * 33], s[14 * 33], s[15 * 33]);
            *(GAS u32x4*)(c.WT + (size_t)(c.drow0 + n) * c.K + c.k0 + 16 * q) = o; }
        LDS_WAIT(); asm volatile("" ::: "memory");
    }
}
__device__ __forceinline__ void p0_prologue(const Ctx& F) {
    LAS float* scr = (LAS float*)(F.lds + F.wave * 16384);
    const int gw = F.vcu * NWAVES + F.wave, NGW = F.G * NWAVES;
    unsigned char* ws = F.ws;
    constexpr int I_IN = 16 * 112, I_OUT = 16 * 32, NITEMS = I_IN + I_OUT;
    for (int it = gw; it < NITEMS; it += NGW) {
        int r = it;
        if (r < I_IN) { const int kb = r / 112, nb = r % 112; p0_transpose_item(F.in[2], DM, NPROJ, (bf16*)(ws + WS_WIN), 64 * kb, 32 * nb, 32 * nb, scr, F.lane, F.in[1]); continue; } r -= I_IN;
        { const int kb = r / 32, nb = r % 32; p0_transpose_item(F.in[6], DM, DM, (bf16*)(ws + WS_WOUT), 64 * kb, 32 * nb, 32 * nb, scr, F.lane, kb < 8 ? F.in[3] : nullptr); }
    }
    { bf16* whi = (bf16*)(ws + WS_WRT); bf16* wlo = whi + 36 * DM; const int gt = F.vcu * NTHR + F.tid, NGT = F.G * NTHR;
      for (int idx = gt; idx < 36 * DM; idx += NGT) { const int o = idx / DM, k = idx % DM; const float w = F.in[7][k] * ((o < 4) ? F.in[8][k * 4 + o] : F.in[10][k * 32 + (o - 4)]);
          const unsigned h = f2bf(w); whi[idx] = (bf16)h; wlo[idx] = (bf16)f2bf(w - __uint_as_float(h << 16)); } }
    const float* x = F.in[0]; bf16* H = (bf16*)(ws + WS_H); float* rs1 = (float*)(ws + WS_SUMSQ);
    for (int m = gw; m < NTOK; m += NGW) {
        const GAS f32x4* xr = (const GAS f32x4*)(x + (size_t)m * DM) + F.lane;
        f32x4 v[4]; float s = 0.f;
#pragma unroll
        for (int j = 0; j < 4; ++j) { v[j] = xr[64 * j]; s += (v[j].x * v[j].x + v[j].y * v[j].y) + (v[j].z * v[j].z + v[j].w * v[j].w); }
        const float rstd = 1.f / sqrtf(wave_sum(s) * (1.f / DM) + EPS);
        if (F.lane == 0) rs1[m] = rstd;
        GAS unsigned long long* o8 = (GAS unsigned long long*)(H + (size_t)m * DM) + F.lane;
#pragma unroll
        for (int j = 0; j < 4; ++j) o8[64 * j] = (unsigned long long)pk2(v[j].x, v[j].y) | ((unsigned long long)pk2(v[j].z, v[j].w) << 32);
    }
}

namespace att {
typedef float f32x16 __attribute__((ext_vector_type(16)));
typedef short s16x4 __attribute__((ext_vector_type(4)));
typedef short v4i16_t __attribute__((ext_vector_type(4)));
typedef __attribute__((address_space(3))) const char* lds_cptr;
constexpr float NEGBIG = -1.0e30f, THR = 12.f;
__device__ __forceinline__ void glds16(const void* gsrc, unsigned lds_dst) { unsigned keep;
    asm volatile("s_mov_b32 %0, m0\n\ts_mov_b32 m0, %2\n\ts_nop 0\n\tglobal_load_lds_dwordx4 %1, off\n\ts_mov_b32 m0, %0" : "=&s"(keep) : "v"(gsrc), "s"(lds_dst) : "memory"); }
__device__ __forceinline__ s16x4 vtr(lds_cptr p) { return __builtin_bit_cast(s16x4, __builtin_amdgcn_ds_read_tr16_b64_v4i16((__attribute__((address_space(3))) v4i16_t*)p)); }
__device__ __forceinline__ float xmax32(float m) { auto rr = __builtin_amdgcn_permlane32_swap(__float_as_uint(m), __float_as_uint(m), false, false); return fmaxf(__uint_as_float(rr[0]), __uint_as_float(rr[1])); }
__device__ __forceinline__ float xsum32(float m) { auto rr = __builtin_amdgcn_permlane32_swap(__float_as_uint(m), __float_as_uint(m), false, false); return __uint_as_float(rr[0]) + __uint_as_float(rr[1]); }
__device__ __forceinline__ unsigned cvtpk(float lo, float hi) { typedef float f2 __attribute__((ext_vector_type(2))); typedef __bf16 b2 __attribute__((ext_vector_type(2))); f2 v = {lo, hi}; b2 b = __builtin_convertvector(v, b2); return __builtin_bit_cast(unsigned, b); }

struct Bufs { const bf16* proj; bf16* po16; float* pl16; bf16* po4; float* pl4; bf16* mix; float* sumsq; };

struct KVAddr { const char* kb0; const char* kb1; const char* vbp; size_t pstep, tstep; };
__device__ __forceinline__ KVAddr kv_addr(const char* pb, int h, int d, int r, int lane) {
    const size_t rowB = (size_t)PPITCH * 2; const int kl8 = lane >> 3, sw = lane >> 4; KVAddr A;
    const char* rowp = pb + (size_t)(kl8 * d + r) * rowB;
    A.kb0 = rowp + (C_K + h * 64) * 2 + (((lane & 7) ^ sw) * 16);
    A.kb1 = rowp + (C_K + h * 64) * 2 + (((lane & 7) ^ (4 + sw)) * 16);
    A.vbp = rowp + (C_V + h * 64) * 2 + (((lane & 7) ^ ((sw & 1) << 2)) * 16);
    A.pstep = (size_t)8 * d * rowB; A.tstep = (size_t)32 * d * rowB; return A; }
__device__ __forceinline__ void kv_dma(const KVAddr& A, int kt, unsigned lb_) {
    const size_t to_ = (size_t)kt * A.tstep;
    glds16(A.kb0 + to_, (unsigned)__builtin_amdgcn_readfirstlane(lb_)); glds16(A.kb1 + to_ + A.pstep, (unsigned)__builtin_amdgcn_readfirstlane(lb_ + 1024u));
    glds16(A.kb0 + to_ + 2 * A.pstep, (unsigned)__builtin_amdgcn_readfirstlane(lb_ + 2048u)); glds16(A.kb1 + to_ + 3 * A.pstep, (unsigned)__builtin_amdgcn_readfirstlane(lb_ + 3072u));
    glds16(A.vbp + to_, (unsigned)__builtin_amdgcn_readfirstlane(lb_ + 4096u)); glds16(A.vbp + to_ + A.pstep, (unsigned)__builtin_amdgcn_readfirstlane(lb_ + 5120u));
    glds16(A.vbp + to_ + 2 * A.pstep, (unsigned)__builtin_amdgcn_readfirstlane(lb_ + 6144u)); glds16(A.vbp + to_ + 3 * A.pstep, (unsigned)__builtin_amdgcn_readfirstlane(lb_ + 7168u)); }

template <int NQ> struct QPre { u32x4 qv[NQ][4]; };
__device__ __forceinline__ void prolog_dma(const Bufs& B, unsigned wl_addr, int b, int h, int d, int r, int u0, int lane_in, int slot) {
    int lane = lane_in; asm volatile("" : "+v"(lane));
    const size_t rowB = (size_t)PPITCH * 2; const char* pb = (const char*)B.proj + (size_t)b * SEQ * rowB;
    const KVAddr A = kv_addr(pb, h, d, r, lane);
    const int jA = u0 >> 5; const int kt0 = (jA - 4) > 0 ? (jA - 4) : 0;
    kv_dma(A, kt0, wl_addr + (unsigned)slot * 8192u);
}
template <int NQ>
__device__ __forceinline__ void prolog_q(const Bufs& B, int b, int h, int d, int r, int u0, int lane_in, QPre<NQ>& P) {
    int lane = lane_in; asm volatile("" : "+v"(lane));
    const size_t rowB = (size_t)PPITCH * 2; const char* pb = (const char*)B.proj + (size_t)b * SEQ * rowB;
    const int kl8 = lane >> 3;
#pragma unroll
    for (int x = 0; x < NQ; ++x)
#pragma unroll
        for (int p = 0; p < 4; ++p) P.qv[x][p] = *(const u32x4*)(pb + (size_t)((u0 + 32 * x + 8 * p + kl8) * d + r) * rowB + (C_Q + h * 64) * 2 + (lane & 7) * 16);
}
struct NoNext { static constexpr int NOPS = 0; __device__ __forceinline__ void dma(int) const {} __device__ __forceinline__ void qload() const {} };
template <int NQN> struct NextPro { const Bufs& B; unsigned wl_addr; int b, h, d, r, u0, lane; QPre<NQN>& P; static constexpr int NOPS = 8;
    __device__ __forceinline__ void dma(int slot) const { prolog_dma(B, wl_addr, b, h, d, r, u0, lane, slot); }
    __device__ __forceinline__ void qload() const { prolog_q<NQN>(B, b, h, d, r, u0, lane, P); } };

template <int NQ> struct Stash { u32x4 v[NQ][4]; float lse[NQ]; };
struct NoFlush { static constexpr int NST = 0; __device__ __forceinline__ void operator()() const {} };
template <int NQP> struct Flush { bf16* po; float* pl; int b, h, d, r, u0, lane; const Stash<NQP>& S; static constexpr int NST = 5 * NQP;
    __device__ __forceinline__ void operator()() const {
        int ln = lane; asm volatile("" : "+v"(ln));
        const int kl8 = ln >> 3, ch = ln & 7, i = ln & 31, hi = ln >> 5;
#pragma unroll
        for (int x = 0; x < NQP; ++x) {
#pragma unroll
            for (int p = 0; p < 4; ++p) { const int tokr = b * SEQ + (u0 + 32 * x + 8 * p + kl8) * d + r; *(u32x4*)(po + (size_t)tokr * POPITCH + h * 64 + ch * 8) = S.v[x][p]; }
            if (hi == 0) pl[(b * 8 + h) * SEQ + r * (SEQ / d) + u0 + 32 * x + i] = S.lse[x]; }
    } };

template <int NQ, int MODE, class Prev, class Next>
__device__ __forceinline__ int qgroup(const Bufs& B, lds_cptr wl, unsigned wl_addr, int b, int h, int d, int r, int u0, float slope2, int lane_in, QPre<NQ>& P, int s0, const Prev& prev, const Next& next, Stash<NQ>& out) {
    int lane = lane_in; asm volatile("" : "+v"(lane));
    constexpr int NST = Prev::NST;
    const int i = lane & 31, hi = lane >> 5;
    const size_t rowB = (size_t)PPITCH * 2;
    const char* pb = (const char*)B.proj + (size_t)b * SEQ * rowB;
    const float sld = slope2 * (float)d; const int iq = i - 4 * hi; const float bl = -sld * (float)(iq + 128);
    const int kl8 = lane >> 3, sw = lane >> 4;
    const KVAddr A = kv_addr(pb, h, d, r, lane);
    const int ksw = (i >> 1) & 7;
    int kaddr[4];
#pragma unroll
    for (int s = 0; s < 4; ++s) kaddr[s] = i * 128 + (((2 * s + hi) ^ ksw) * 16);
    const int g16 = lane >> 4, i16 = lane & 15, kbit = (i16 >> 3) & 1, vrow = 4 * hi + (i16 >> 2), vcol = 2 * (g16 & 1) + ((i16 & 3) >> 1), vb8 = (i16 & 1) * 8;
    const int va0 = 4096 + vrow * 128 + (vcol + 4 * kbit) * 16 + vb8, va1 = 4096 + vrow * 128 + (vcol + 4 * (1 - kbit)) * 16 + vb8;
    const int jA = u0 >> 5; const int kt0 = (jA - 4) > 0 ? (jA - 4) : 0, kt1 = jA + NQ - 1;
    f32x16 O[NQ][2]; float lsum[NQ], mrun[NQ];
#pragma unroll
    for (int x = 0; x < NQ; ++x) { lsum[x] = 0.f; mrun[x] = 0.f;
#pragma unroll
        for (int e = 0; e < 16; ++e) { O[x][0][e] = 0.f; O[x][1][e] = 0.f; } }
    bf16x8 qf[NQ][4];
    { typedef __attribute__((address_space(3))) unsigned char* lds_pq; const lds_pq qs = (lds_pq)wl + (s0 ^ 1) * 8192;
#pragma unroll
      for (int x = 0; x < NQ; ++x)
#pragma unroll
          for (int p = 0; p < 4; ++p) *(__attribute__((address_space(3))) u32x4*)(qs + x * 4096 + (8 * p + kl8) * 128 + (((lane & 7) ^ (4 * (p & 1) + sw)) * 16)) = P.qv[x][p];
      asm volatile("s_waitcnt lgkmcnt(0)" ::: "memory"); __builtin_amdgcn_wave_barrier();
#pragma unroll
      for (int x = 0; x < NQ; ++x)
#pragma unroll
          for (int s = 0; s < 4; ++s) qf[x][s] = *(const __attribute__((address_space(3))) bf16x8*)(qs + x * 4096 + kaddr[s]);
      asm volatile("s_waitcnt lgkmcnt(0)" ::: "memory"); __builtin_amdgcn_wave_barrier(); }
    if (kt0 < kt1) kv_dma(A, kt0 + 1, wl_addr + (unsigned)(s0 ^ 1) * 8192u); else next.dma(s0 ^ 1);
    prev();
    for (int kt = kt0; kt <= kt1; ++kt) {
        const int slot = ((kt - kt0) & 1) ^ s0;
        if (kt > kt0) { if (kt < kt1) kv_dma(A, kt + 1, wl_addr + (unsigned)(slot ^ 1) * 8192u); else next.dma(slot ^ 1); }
        if (kt < kt1 || Next::NOPS == 8) { if (kt - kt0 < 2) asm volatile("s_waitcnt vmcnt(%0)" :: "n"(8 + NST) : "memory"); else asm volatile("s_waitcnt vmcnt(8)" ::: "memory"); }
        else { if (kt - kt0 < 2) asm volatile("s_waitcnt vmcnt(%0)" :: "n"(NST) : "memory"); else asm volatile("s_waitcnt vmcnt(0)" ::: "memory"); }
        const lds_cptr sl = wl + slot * 8192;
        bf16x8 kf[4];
#pragma unroll
        for (int s = 0; s < 4; ++s) kf[s] = *(const __attribute__((address_space(3))) bf16x8*)(sl + kaddr[s]);
        bf16x8 vf[2][2];
#pragma unroll
        for (int ks = 0; ks < 2; ++ks) {
            const s16x4 a0 = vtr(sl + va0 + 2048 * ks), a1 = vtr(sl + va0 + 2048 * ks + 1024), b0 = vtr(sl + va1 + 2048 * ks), b1 = vtr(sl + va1 + 2048 * ks + 1024);
            vf[0][ks] = (bf16x8){a0[0], a0[1], a0[2], a0[3], a1[0], a1[1], a1[2], a1[3]};
            vf[1][ks] = (bf16x8){b0[0], b0[1], b0[2], b0[3], b1[0], b1[1], b1[2], b1[3]}; }
#pragma unroll
        for (int x = 0; x < NQ; ++x) {
            const int c = kt - (jA + x - 4);
            if (c >= 0 && c <= 4) {
                const int ktf = (jA + x - 4) > 0 ? (jA + x - 4) : 0;
                const bool first = (kt == ktf);
                const float base = bl + sld * (float)(32 * c) - (first ? 0.f : mrun[x]);
                f32x16 S;
#pragma unroll
                for (int e = 0; e < 16; ++e) S[e] = base + sld * (float)((e & 3) + 8 * (e >> 2));
                if (c == 0) {
#pragma unroll
                    for (int e = 0; e < 16; ++e) S[e] = (((e & 3) + 8 * (e >> 2)) >= iq) ? S[e] : NEGBIG; }
                if (c == 4) {
#pragma unroll
                    for (int e = 0; e < 16; ++e) S[e] = (((e & 3) + 8 * (e >> 2)) <= iq) ? S[e] : NEGBIG; }
#pragma unroll
                for (int s = 0; s < 4; ++s) S = __builtin_amdgcn_mfma_f32_32x32x16_bf16(kf[s], qf[x][s], S, 0, 0, 0);
                float mx = fmaxf(fmaxf(S[0], S[1]), fmaxf(S[2], S[3]));
#pragma unroll
                for (int e = 4; e < 16; e += 4) mx = fmaxf(mx, fmaxf(fmaxf(S[e], S[e + 1]), fmaxf(S[e + 2], S[e + 3])));
                mx = xmax32(mx);
                if (first) { mrun[x] = mx;
#pragma unroll
                    for (int e = 0; e < 16; ++e) S[e] -= mx; }
                else if (__any(mx > THR)) { const float dl = fmaxf(mx, 0.f); mrun[x] += dl; const float al = __builtin_amdgcn_exp2f(-dl); lsum[x] *= al;
#pragma unroll
                    for (int e = 0; e < 16; ++e) { S[e] -= dl; O[x][0][e] *= al; O[x][1][e] *= al; } }
                float ps = 0.f;
#pragma unroll
                for (int e = 0; e < 16; ++e) { S[e] = __builtin_amdgcn_exp2f(S[e]); ps += S[e]; }
                lsum[x] += ps;
                u32x4 w0, w1;
                w0.x = cvtpk(S[0], S[1]); w0.y = cvtpk(S[2], S[3]); w0.z = cvtpk(S[4], S[5]); w0.w = cvtpk(S[6], S[7]);
                w1.x = cvtpk(S[8], S[9]); w1.y = cvtpk(S[10], S[11]); w1.z = cvtpk(S[12], S[13]); w1.w = cvtpk(S[14], S[15]);
                const bf16x8 p0 = __builtin_bit_cast(bf16x8, w0), p1 = __builtin_bit_cast(bf16x8, w1);
                O[x][0] = __builtin_amdgcn_mfma_f32_32x32x16_bf16(vf[0][0], p0, O[x][0], 0, 0, 0);
                O[x][0] = __builtin_amdgcn_mfma_f32_32x32x16_bf16(vf[0][1], p1, O[x][0], 0, 0, 0);
                O[x][1] = __builtin_amdgcn_mfma_f32_32x32x16_bf16(vf[1][0], p0, O[x][1], 0, 0, 0);
                O[x][1] = __builtin_amdgcn_mfma_f32_32x32x16_bf16(vf[1][1], p1, O[x][1], 0, 0, 0);
            }
        }
    }
    const int slast = ((kt1 - kt0) & 1) ^ s0;
    next.qload();
    typedef __attribute__((address_space(3))) unsigned char* lds_p;
    const int ch = lane & 7;
    if (MODE == 0) {
        const lds_p stg = (lds_p)wl + slast * 8192;
#pragma unroll
        for (int x = 0; x < NQ; ++x) {
            const float lt = xsum32(lsum[x]);
            const lds_p st = stg + x * 4096;
            const float inv = 1.f / lt;
#pragma unroll
            for (int blk = 0; blk < 2; ++blk)
#pragma unroll
                for (int rg = 0; rg < 4; ++rg) { u32x2 w; w.x = cvtpk(O[x][blk][4 * rg] * inv, O[x][blk][4 * rg + 1] * inv); w.y = cvtpk(O[x][blk][4 * rg + 2] * inv, O[x][blk][4 * rg + 3] * inv);
                    *(__attribute__((address_space(3))) u32x2*)(st + i * 128 + (((4 * blk + rg) ^ (i & 7)) * 16) + 8 * hi) = w; }
            out.lse[x] = mrun[x] + __builtin_amdgcn_logf(lt);
        }
        asm volatile("s_waitcnt lgkmcnt(0)" ::: "memory"); __builtin_amdgcn_wave_barrier();
#pragma unroll
        for (int x = 0; x < NQ; ++x)
#pragma unroll
            for (int p = 0; p < 4; ++p) out.v[x][p] = *(const __attribute__((address_space(3))) u32x4*)(stg + x * 4096 + (8 * p + kl8) * 128 + ((ch ^ kl8) * 16));
    } else {
        const lds_p stg = (lds_p)wl;
        asm volatile("s_waitcnt vmcnt(0)" ::: "memory"); __syncthreads();
        u32x4 pa16[4], pa4[4], pb16[4], pb4[4]; float la16, la4, lb16 = 0.f, lb4 = 0.f;
        const float* l16p = B.pl16 + (b * 8 + h) * SEQ; const float* l4p = B.pl4 + (b * 8 + h) * SEQ;
#pragma unroll
        for (int p = 0; p < 4; ++p) { const int tokr = b * SEQ + (u0 + 8 * p + kl8) * d + r;
            pa16[p] = *(const u32x4*)(B.po16 + (size_t)tokr * POPITCH + h * 64 + ch * 8); pa4[p] = *(const u32x4*)(B.po4 + (size_t)tokr * POPITCH + h * 64 + ch * 8); }
        { const int t = u0 + i; la16 = l16p[(t & 15) * (SEQ / 16) + (t >> 4)]; la4 = l4p[(t & 3) * (SEQ / 4) + (t >> 2)]; }
        if (NQ == 2) {
#pragma unroll
            for (int p = 0; p < 4; ++p) { const int tokr = b * SEQ + (u0 + 32 + 8 * p + kl8) * d + r;
                pb16[p] = *(const u32x4*)(B.po16 + (size_t)tokr * POPITCH + h * 64 + ch * 8); pb4[p] = *(const u32x4*)(B.po4 + (size_t)tokr * POPITCH + h * 64 + ch * 8); }
            const int t = u0 + 32 + i; lb16 = l16p[(t & 15) * (SEQ / 16) + (t >> 4)]; lb4 = l4p[(t & 3) * (SEQ / 4) + (t >> 2)]; }
#pragma unroll
        for (int x = 0; x < NQ; ++x) {
            const float lt = xsum32(lsum[x]);
            const lds_p st = stg + x * 4608;
            u32x4 p16[4], p4[4];
#pragma unroll
            for (int p = 0; p < 4; ++p) { p16[p] = x ? pb16[p] : pa16[p]; p4[p] = x ? pb4[p] : pa4[p]; }
            const float l16 = x ? lb16 : la16, l4 = x ? lb4 : la4;
            const float M = fmaxf(fmaxf(mrun[x], l16), l4);
            const float w1 = __builtin_amdgcn_exp2f(mrun[x] - M), w16 = __builtin_amdgcn_exp2f(l16 - M), w4 = __builtin_amdgcn_exp2f(l4 - M);
            const float den = 1.f / (w1 * lt + w16 + w4); const float inv = 1.f / lt;
#pragma unroll
            for (int blk = 0; blk < 2; ++blk)
#pragma unroll
                for (int rg = 0; rg < 4; ++rg) { u32x2 w; w.x = cvtpk(O[x][blk][4 * rg] * inv, O[x][blk][4 * rg + 1] * inv); w.y = cvtpk(O[x][blk][4 * rg + 2] * inv, O[x][blk][4 * rg + 3] * inv);
                    *(__attribute__((address_space(3))) u32x2*)(st + i * 144 + 64 * blk + 16 * rg + 8 * hi) = w; }
            if (hi == 0) *(__attribute__((address_space(3))) f32x4*)(stg + 9216 + x * 512 + i * 16) = (f32x4){w1 * lt * den, w16 * den, w4 * den, 0.f};
            asm volatile("s_waitcnt lgkmcnt(0)" ::: "memory"); __builtin_amdgcn_wave_barrier();
            float myss = 0.f;
#pragma unroll
            for (int p = 0; p < 4; ++p) { const int row = 8 * p + kl8; const int tokr = b * SEQ + (u0 + 32 * x + row) * d + r;
                const u32x4 ov = *(const __attribute__((address_space(3))) u32x4*)(st + row * 144 + ch * 16);
                const f32x4 av = *(const __attribute__((address_space(3))) f32x4*)(stg + 9216 + x * 512 + row * 16);
                const u32x4 a = p16[p], c4 = p4[p];
                const float o0 = av.x * bflo(ov.x) + av.y * bflo(a.x) + av.z * bflo(c4.x), o1 = av.x * bfhi(ov.x) + av.y * bfhi(a.x) + av.z * bfhi(c4.x);
                const float o2 = av.x * bflo(ov.y) + av.y * bflo(a.y) + av.z * bflo(c4.y), o3 = av.x * bfhi(ov.y) + av.y * bfhi(a.y) + av.z * bfhi(c4.y);
                const float o4 = av.x * bflo(ov.z) + av.y * bflo(a.z) + av.z * bflo(c4.z), o5 = av.x * bfhi(ov.z) + av.y * bfhi(a.z) + av.z * bfhi(c4.z);
                const float o6 = av.x * bflo(ov.w) + av.y * bflo(a.w) + av.z * bflo(c4.w), o7 = av.x * bfhi(ov.w) + av.y * bfhi(a.w) + av.z * bfhi(c4.w);
                float ss = (o0 * o0 + o1 * o1) + (o2 * o2 + o3 * o3) + (o4 * o4 + o5 * o5) + (o6 * o6 + o7 * o7);
                ss += __shfl_xor(ss, 1); ss += __shfl_xor(ss, 2); ss += __shfl_xor(ss, 4);
                u32x4 w; w.x = cvtpk(o0, o1); w.y = cvtpk(o2, o3); w.z = cvtpk(o4, o5); w.w = cvtpk(o6, o7);
                *(u32x4*)(B.mix + (size_t)tokr * DM + h * 64 + ch * 8) = w;
                myss = (ch == p) ? ss : myss; }
            if (ch < 4) B.sumsq[(b * 8 + h) * SEQ + u0 + 32 * x + 8 * ch + kl8] = myss;
        }
    }
    asm volatile("s_waitcnt lgkmcnt(0)" ::: "memory"); __builtin_amdgcn_wave_barrier();
    return slast ^ 1;
}

__device__ __forceinline__ void item(const Bufs& B, lds_cptr wl, unsigned wl_addr, int b, int s, int h, int wave, int lane) {
    const float slope2 = exp2f(-(float)(h + 1)) * LOG2E;
    QPre<1> Pa, Pb; QPre<2> Pc, Pd; Stash<1> Sa, Sb; Stash<2> Sc, Sd;
    prolog_dma(B, wl_addr, b, h, 16, 2 * wave, 32 * s, lane, 0); prolog_q<1>(B, b, h, 16, 2 * wave, 32 * s, lane, Pa);
    int s0 = 0;
    s0 = qgroup<1, 0>(B, wl, wl_addr, b, h, 16, 2 * wave, 32 * s, slope2, lane, Pa, s0, NoFlush{}, NextPro<1>{B, wl_addr, b, h, 16, 2 * wave + 1, 32 * s, lane, Pb}, Sa);
    s0 = qgroup<1, 0>(B, wl, wl_addr, b, h, 16, 2 * wave + 1, 32 * s, slope2, lane, Pb, s0, Flush<1>{B.po16, B.pl16, b, h, 16, 2 * wave, 32 * s, lane, Sa},
                      NextPro<2>{B, wl_addr, b, h, 4, wave >> 1, 128 * s + 64 * (wave & 1), lane, Pc}, Sb);
    s0 = qgroup<2, 0>(B, wl, wl_addr, b, h, 4, wave >> 1, 128 * s + 64 * (wave & 1), slope2, lane, Pc, s0, Flush<1>{B.po16, B.pl16, b, h, 16, 2 * wave + 1, 32 * s, lane, Sb},
                      NextPro<2>{B, wl_addr, b, h, 1, 0, 512 * s + 64 * wave, lane, Pd}, Sc);
    qgroup<2, 1>(B, wl, wl_addr, b, h, 1, 0, 512 * s + 64 * wave, slope2, lane, Pd, s0, Flush<2>{B.po4, B.pl4, b, h, 4, wave >> 1, 128 * s + 64 * (wave & 1), lane, Sc}, NoNext{}, Sd);
}
}

namespace hg {
using att::f32x16; using att::s16x4; using att::lds_cptr; using att::vtr; using att::cvtpk; using att::xsum32; using att::glds16;
typedef __attribute__((address_space(3))) unsigned short* lds_u16p;
__device__ __forceinline__ void item(const Ctx& F, int b, int h) {
    const bf16* proj = (const bf16*)(F.ws + WS_PROJ); bf16* mix = (bf16*)(F.ws + WS_MIX);
    const float* gamma = F.in[4]; const float* ghn = F.in[5];
    int lane = F.lane, tid = F.tid; const int wave = F.wave;
    asm volatile("" : "+v"(lane), "+v"(tid));
    LAS unsigned char* wl = F.lds + wave * 16384;
    const unsigned wl_addr = (unsigned)(uintptr_t)wl;
    LAS float* decay = (LAS float*)(F.lds + LDS_TAB);
    LAS float* gnl = (LAS float*)(F.lds + LDS_TAB + 2048);
    const int i = lane & 31, hi = lane >> 5, iq = i - 4 * hi;
    const float lb = 1.f / (1.f + __expf(gamma[512 + h * 64 + lane] - gamma[h * 64 + lane])), oml = 1.f - lb;
    if (wave == 0) gnl[lane] = ghn[h * 64 + lane];
    float Sf[8];
#pragma unroll
    for (int j = 0; j < 8; ++j) Sf[j] = 0.f;
    const int sv = tid >> 3, sko = tid & 7;
    const int ksw = (i >> 1) & 7;
    int raddr[4];
#pragma unroll
    for (int s = 0; s < 4; ++s) raddr[s] = i * 128 + (((2 * s + hi) ^ ksw) * 16);
    const int g16 = lane >> 4, i16 = lane & 15, kbit = (i16 >> 3) & 1, vrow = 4 * hi + (i16 >> 2), vcol = 2 * (g16 & 1) + ((i16 & 3) >> 1), vb8 = (i16 & 1) * 8;
    const int ta0 = vrow * 128 + (vcol + 4 * kbit) * 16 + vb8, ta1 = vrow * 128 + (vcol + 4 * (1 - kbit)) * 16 + vb8;
    const size_t rowB = (size_t)PPITCH * 2;
    const int kl8 = lane >> 3, sw = lane >> 4;
    const char* cb = (const char*)proj + ((size_t)b * SEQ + wave * 32 + kl8) * rowB + (size_t)h * 128;
    const int rs0 = ((lane & 7) ^ sw) * 16, rs1 = ((lane & 7) ^ (4 + sw)) * 16, vs0 = ((lane & 7) ^ ((sw & 1) << 2)) * 16;
    const size_t pstep = 8 * rowB, gstep = 256 * rowB;
#define HG_DMA_R(colbytes, grp_, region) do { const char* s_ = cb + (size_t)(grp_) * gstep + (colbytes); const unsigned lb_ = wl_addr + (region); \
        glds16(s_ + rs0, (unsigned)__builtin_amdgcn_readfirstlane(lb_)); glds16(s_ + pstep + rs1, (unsigned)__builtin_amdgcn_readfirstlane(lb_ + 1024u)); \
        glds16(s_ + 2 * pstep + rs0, (unsigned)__builtin_amdgcn_readfirstlane(lb_ + 2048u)); glds16(s_ + 3 * pstep + rs1, (unsigned)__builtin_amdgcn_readfirstlane(lb_ + 3072u)); } while (0)
#define HG_DMA_V(colbytes, grp_, region) do { const char* s_ = cb + (size_t)(grp_) * gstep + (colbytes) + vs0; const unsigned lb_ = wl_addr + (region); \
        glds16(s_, (unsigned)__builtin_amdgcn_readfirstlane(lb_)); glds16(s_ + pstep, (unsigned)__builtin_amdgcn_readfirstlane(lb_ + 1024u)); \
        glds16(s_ + 2 * pstep, (unsigned)__builtin_amdgcn_readfirstlane(lb_ + 2048u)); glds16(s_ + 3 * pstep, (unsigned)__builtin_amdgcn_readfirstlane(lb_ + 3072u)); } while (0)
    HG_DMA_R(C_HQ * 2, 0, 0u); HG_DMA_R(C_HF * 2, 0, 4096u); HG_DMA_V(C_HI * 2, 0, 12288u);
    for (int grp = 0; grp < 8; ++grp) {
        const int tok0 = b * SEQ + (grp * 8 + wave) * 32;
        if (grp == 0) asm volatile("s_waitcnt vmcnt(0)" ::: "memory"); else asm volatile("s_waitcnt vmcnt(8)" ::: "memory");
        {
            float E1 = 1.f;
            const int kc = lane >> 3, kw = (lane & 7) * 2;
#pragma unroll
            for (int tb = 0; tb < 4; ++tb) {
                float qv[8], fr[8];
#pragma unroll
                for (int j = 0; j < 8; ++j) { const int t = 8 * tb + j; const int rsw = (kc ^ ((t >> 1) & 7)) * 16 + kw;
                    qv[j] = bf2f(*(lds_u16p)(wl + t * 128 + rsw)); fr[j] = bf2f(*(lds_u16p)(wl + 4096 + t * 128 + rsw)); }
                float ff[8], ky[8], qs[8], ee[8];
#pragma unroll
                for (int j = 0; j < 8; ++j) { const float sg = __builtin_amdgcn_rcpf(1.f + __builtin_amdgcn_exp2f(-fr[j] * LOG2E));
                    ff[j] = lb + oml * sg; ky[j] = oml * (1.f - sg);
                    qs[j] = qv[j] * __builtin_amdgcn_rcpf(1.f + __builtin_amdgcn_exp2f(-qv[j] * LOG2E)); }
#pragma unroll
                for (int j = 0; j < 8; ++j) { E1 *= ff[j]; ee[j] = E1; }
#pragma unroll
                for (int j = 0; j < 8; ++j) { const int t = 8 * tb + j; const int rsw = (kc ^ ((t >> 1) & 7)) * 16 + kw;
                    const unsigned pk = cvtpk(qs[j] * ee[j], ky[j] * __builtin_amdgcn_rcpf(ee[j]));
                    *(lds_u16p)(wl + t * 128 + rsw) = (unsigned short)pk;
                    *(lds_u16p)(wl + 4096 + t * 128 + rsw) = (unsigned short)(pk >> 16); }
            }
            decay[wave * 64 + lane] = E1;
        }
        asm volatile("s_waitcnt lgkmcnt(0)" ::: "memory"); __builtin_amdgcn_wave_barrier();
        bf16x8 qfB[4];
        f32x16 oT[2];
        u32x4 gpre[4];
        {
            f32x16 AT;
#pragma unroll
            for (int e = 0; e < 16; ++e) AT[e] = 0.f;
#pragma unroll
            for (int s = 0; s < 4; ++s) { qfB[s] = *(const LAS bf16x8*)(wl + raddr[s]); const bf16x8 kfA = *(const LAS bf16x8*)(wl + 4096 + raddr[s]);
                AT = __builtin_amdgcn_mfma_f32_32x32x16_bf16(kfA, qfB[s], AT, 0, 0, 0); }
            asm volatile("s_waitcnt lgkmcnt(0)" ::: "memory");
            if (grp < 7) { HG_DMA_R(C_HQ * 2, grp + 1, 0u); asm volatile("s_waitcnt vmcnt(4)" ::: "memory"); } else asm volatile("s_waitcnt vmcnt(0)" ::: "memory");
#pragma unroll
            for (int e = 0; e < 16; ++e) AT[e] = (((e & 3) + 8 * (e >> 2)) <= iq) ? AT[e] : 0.f;
            u32x4 w0, w1;
            w0.x = cvtpk(AT[0], AT[1]); w0.y = cvtpk(AT[2], AT[3]); w0.z = cvtpk(AT[4], AT[5]); w0.w = cvtpk(AT[6], AT[7]);
            w1.x = cvtpk(AT[8], AT[9]); w1.y = cvtpk(AT[10], AT[11]); w1.z = cvtpk(AT[12], AT[13]); w1.w = cvtpk(AT[14], AT[15]);
            const bf16x8 p0 = __builtin_bit_cast(bf16x8, w0), p1 = __builtin_bit_cast(bf16x8, w1);
            bf16x8 vf[2][2], ef[2][2];
            const lds_cptr vs = (lds_cptr)(wl + 12288), es = (lds_cptr)(wl + 4096);
            const int swk = 2 * hi + kbit;
#pragma unroll
            for (int ks = 0; ks < 2; ++ks) {
                const s16x4 a0 = vtr(vs + ta0 + 2048 * ks), a1 = vtr(vs + ta0 + 2048 * ks + 1024), b0 = vtr(vs + ta1 + 2048 * ks), b1 = vtr(vs + ta1 + 2048 * ks + 1024);
                vf[0][ks] = (bf16x8){a0[0], a0[1], a0[2], a0[3], a1[0], a1[1], a1[2], a1[3]}; vf[1][ks] = (bf16x8){b0[0], b0[1], b0[2], b0[3], b1[0], b1[1], b1[2], b1[3]};
#pragma unroll
                for (int kb = 0; kb < 2; ++kb) {
                    const s16x4 c0 = vtr(es + 2048 * ks + vrow * 128 + (((4 * kb + vcol) ^ swk) * 16) + vb8);
                    const s16x4 c1 = vtr(es + 2048 * ks + 1024 + vrow * 128 + (((4 * kb + vcol) ^ (4 + swk)) * 16) + vb8);
                    ef[kb][ks] = (bf16x8){c0[0], c0[1], c0[2], c0[3], c1[0], c1[1], c1[2], c1[3]}; }
            }
#pragma unroll
            for (int vb = 0; vb < 2; ++vb) {
#pragma unroll
                for (int e = 0; e < 16; ++e) oT[vb][e] = 0.f;
                oT[vb] = __builtin_amdgcn_mfma_f32_32x32x16_bf16(vf[vb][0], p0, oT[vb], 0, 0, 0);
                oT[vb] = __builtin_amdgcn_mfma_f32_32x32x16_bf16(vf[vb][1], p1, oT[vb], 0, 0, 0); }
#pragma unroll
            for (int kb = 0; kb < 2; ++kb)
#pragma unroll
                for (int vb = 0; vb < 2; ++vb) {
                    f32x16 dS;
#pragma unroll
                    for (int e = 0; e < 16; ++e) dS[e] = 0.f;
                    dS = __builtin_amdgcn_mfma_f32_32x32x16_bf16(ef[kb][0], vf[vb][0], dS, 0, 0, 0);
                    dS = __builtin_amdgcn_mfma_f32_32x32x16_bf16(ef[kb][1], vf[vb][1], dS, 0, 0, 0);
                    const int v = 32 * vb + i;
#pragma unroll
                    for (int rg = 0; rg < 4; ++rg) { u32x2 w; w.x = cvtpk(dS[4 * rg], dS[4 * rg + 1]); w.y = cvtpk(dS[4 * rg + 2], dS[4 * rg + 3]);
                        *(LAS u32x2*)(wl + 8192 + vb * 4096 + i * 128 + (((4 * kb + rg) ^ (i & 7)) * 16) + 8 * hi) = w; }
                }
            if (grp < 7) HG_DMA_R(C_HF * 2, grp + 1, 4096u);
            { const bf16* grow = proj + (size_t)(tok0 + (lane >> 3)) * PPITCH + C_HG + h * 64 + 8 * (lane & 7);
#pragma unroll
              for (int p = 0; p < 4; ++p) gpre[p] = *(const u32x4*)(grow + (size_t)(8 * p) * PPITCH); }
        }
        __syncthreads();
#pragma unroll
        for (int c = 0; c < 8; ++c) {
            LAS u32x4* sp = (LAS u32x4*)(F.lds + c * 16384 + 8192 + (sv >> 5) * 4096 + (sv & 31) * 128 + ((sko ^ (sv & 7)) * 16));
            const u32x4 dv = *sp; const f32x4 d0 = *(const LAS f32x4*)(decay + c * 64 + 8 * sko), d1 = *(const LAS f32x4*)(decay + c * 64 + 8 * sko + 4);
            u32x4 o; o.x = cvtpk(Sf[0], Sf[1]); o.y = cvtpk(Sf[2], Sf[3]); o.z = cvtpk(Sf[4], Sf[5]); o.w = cvtpk(Sf[6], Sf[7]);
            *sp = o;
            Sf[0] = d0.x * (Sf[0] + bflo(dv.x)); Sf[1] = d0.y * (Sf[1] + bfhi(dv.x)); Sf[2] = d0.z * (Sf[2] + bflo(dv.y)); Sf[3] = d0.w * (Sf[3] + bfhi(dv.y));
            Sf[4] = d1.x * (Sf[4] + bflo(dv.z)); Sf[5] = d1.y * (Sf[5] + bfhi(dv.z)); Sf[6] = d1.z * (Sf[6] + bflo(dv.w)); Sf[7] = d1.w * (Sf[7] + bfhi(dv.w));
        }
        __syncthreads();
        {
            bf16x8 sf[2][4];
#pragma unroll
            for (int vb = 0; vb < 2; ++vb) { const int v = 32 * vb + i;
#pragma unroll
                for (int s = 0; s < 4; ++s) sf[vb][s] = *(const LAS bf16x8*)(wl + 8192 + vb * 4096 + i * 128 + (((2 * s + hi) ^ (i & 7)) * 16)); }
            asm volatile("s_waitcnt lgkmcnt(0)" ::: "memory");
#pragma unroll
            for (int vb = 0; vb < 2; ++vb)
#pragma unroll
                for (int s = 0; s < 4; ++s) oT[vb] = __builtin_amdgcn_mfma_f32_32x32x16_bf16(sf[vb][s], qfB[s], oT[vb], 0, 0, 0);
        }
        {
            float ss = 0.f;
#pragma unroll
            for (int vb = 0; vb < 2; ++vb)
#pragma unroll
                for (int e = 0; e < 16; ++e) ss += oT[vb][e] * oT[vb][e];
            ss = xsum32(ss);
            const float rstd = 1.f / sqrtf(ss * (1.f / 64.f) + EPS);
            LAS unsigned char* st = wl + 8192;
#pragma unroll
            for (int vb = 0; vb < 2; ++vb)
#pragma unroll
                for (int rg = 0; rg < 4; ++rg) { u32x2 w; w.x = cvtpk(oT[vb][4 * rg] * rstd, oT[vb][4 * rg + 1] * rstd); w.y = cvtpk(oT[vb][4 * rg + 2] * rstd, oT[vb][4 * rg + 3] * rstd);
                    *(LAS u32x2*)(st + i * 128 + (((4 * vb + rg) ^ (i & 7)) * 16) + 8 * hi) = w; }
            asm volatile("s_waitcnt lgkmcnt(0)" ::: "memory"); __builtin_amdgcn_wave_barrier();
            const int ch = lane & 7, r8 = lane >> 3;
            const f32x4 gw0 = *(const LAS f32x4*)(gnl + 8 * ch), gw1 = *(const LAS f32x4*)(gnl + 8 * ch + 4);
#pragma unroll
            for (int p = 0; p < 4; ++p) { const int row = 8 * p + r8; const u32x4 ov = *(const LAS u32x4*)(st + row * 128 + ((ch ^ (row & 7)) * 16)); const u32x4 gp = gpre[p];
                u32x4 w;
                w.x = cvtpk(bflo(ov.x) * gw0.x * pg8::silu_f(bflo(gp.x)), bfhi(ov.x) * gw0.y * pg8::silu_f(bfhi(gp.x)));
                w.y = cvtpk(bflo(ov.y) * gw0.z * pg8::silu_f(bflo(gp.y)), bfhi(ov.y) * gw0.w * pg8::silu_f(bfhi(gp.y)));
                w.z = cvtpk(bflo(ov.z) * gw1.x * pg8::silu_f(bflo(gp.z)), bfhi(ov.z) * gw1.y * pg8::silu_f(bfhi(gp.z)));
                w.w = cvtpk(bflo(ov.w) * gw1.z * pg8::silu_f(bflo(gp.w)), bfhi(ov.w) * gw1.w * pg8::silu_f(bfhi(gp.w)));
                *(u32x4*)(mix + (size_t)(tok0 + row) * DM + 512 + h * 64 + 8 * ch) = w; }
            asm volatile("s_waitcnt lgkmcnt(0)" ::: "memory"); __builtin_amdgcn_wave_barrier();
            if (grp < 7) HG_DMA_V(C_HI * 2, grp + 1, 12288u);
        }
    }
#undef HG_DMA_R
#undef HG_DMA_V
}
}

constexpr int CW_Q = 12288;
__device__ __forceinline__ void mixer_phase(const Ctx& F, int qoff) {
    att::Bufs B; B.proj = (const bf16*)(F.ws + WS_PROJ);
    unsigned char* scr = (unsigned char*)F.out;
    B.po16 = (bf16*)scr; B.po4 = (bf16*)(scr + 40 * MiB); B.pl16 = (float*)(scr + 80 * MiB); B.pl4 = (float*)(scr + 81 * MiB);
    B.mix = (bf16*)(F.ws + WS_MIX); B.sumsq = (float*)(F.ws + WS_SUMSQ);
    const att::lds_cptr wl = (att::lds_cptr)(F.lds + F.wave * 16384);
    const unsigned wl_addr = (unsigned)(uintptr_t)(F.lds + F.wave * 16384);
    unsigned* q = (unsigned*)(F.ws + WS_CTL) + CW_Q + qoff;
    volatile LAS unsigned* MISC = (volatile LAS unsigned*)(F.lds + LDS_MISC);
    for (;;) {
        __syncthreads();
        if (F.tid == 0) MISC[16] = __hip_atomic_fetch_add(q, 1u, __ATOMIC_RELAXED, __HIP_MEMORY_SCOPE_AGENT);
        __syncthreads();
        const int id = (int)__builtin_amdgcn_readfirstlane(MISC[16]);
        if (id >= 896) break;
        if (id < 128) { hg::item(F, id >> 3, id & 7); continue; }
        int a = -1, c = -1;
        if (id < 128 + 640) { const int g = (id - 128) / 5, rr = (id - 128) % 5; if (rr < 4) a = 4 * g + rr; else c = g; }
        else c = 128 + (id - 768);
        if (a >= 0) att::item(B, wl, wl_addr, (a & 127) >> 3, 3 - (a >> 7), a & 7, F.wave, F.lane);
        else {
            LAS float* scr = (LAS float*)(F.lds + F.wave * 16384);
            for (int j = 0; j < 4; ++j) { const int t0 = 64 * c + 8 * F.wave + 2 * j;
                moe_convert_pair(F, (t0 >> 9) * 768 + (t0 & 511), ((t0 + 1) >> 9) * 768 + ((t0 + 1) & 511), scr, F.lane); } }
    }
}

constexpr int RT_ROWB = 2064;
__device__ __forceinline__ void route_mfma(const Ctx& F, const bool probe = false) {
    const bf16* x2 = (const bf16*)(F.ws + WS_H); unsigned char* H = (unsigned char*)(F.ws + WS_MIX); const float* g2 = F.in[7]; const bf16* wrt = (const bf16*)(F.ws + WS_WRT);
    const float* bgrp = F.in[9]; const float* bexp = F.in[11];
    int* tokl = (int*)(F.ws + (probe ? WS_PROJ : WS_TOKL)); float* gatel = (float*)(F.ws + (probe ? WS_PROJ + 8 * MiB : WS_GATEL)); int* slot = (int*)(F.ws + (probe ? WS_PROJ + 16 * MiB : WS_SLOT));
    unsigned* ctl = (unsigned*)(F.ws + WS_CTL) + (probe ? 4096 : 0); const float* ss2 = (const float*)(F.ws + WS_SSP);
    LAS unsigned char* wl = F.lds;
    LAS int* hist = (LAS int*)(F.lds + LDS_TAB);
    LAS int* gbase = hist + 32;
    LAS int* sel_e = gbase + 32;
    LAS int* sel_r = sel_e + 256;
    LAS float* sel_g = (LAS float*)(sel_r + 256);
    const int lane = F.lane, col = lane & 15, kq = lane >> 4;
    LAS unsigned char* g2l = F.lds + 2 * 36 * RT_ROWB;
    if (F.tid < 128) { const f32x4 ga = *(const f32x4*)(g2 + 8 * F.tid), gb = *(const f32x4*)(g2 + 8 * F.tid + 4);
        u32x4 gp; gp.x = att::cvtpk(ga.x, ga.y); gp.y = att::cvtpk(ga.z, ga.w); gp.z = att::cvtpk(gb.x, gb.y); gp.w = att::cvtpk(gb.z, gb.w); *(LAS u32x4*)(g2l + 16 * F.tid) = gp; }
    u32x4 xpre[16]; float ssq = 0.f;
    if (F.vcu < NTOK / 128) { const int tok = F.vcu * 128 + F.wave * 16 + col; { float pv[16];
#pragma unroll
            for (int j = 0; j < 16; ++j) pv[j] = ss2[(size_t)j * NTOK + tok];
            ssq = (((pv[0] + pv[1]) + (pv[2] + pv[3])) + ((pv[4] + pv[5]) + (pv[6] + pv[7]))) + (((pv[8] + pv[9]) + (pv[10] + pv[11])) + ((pv[12] + pv[13]) + (pv[14] + pv[15]))); }
        const bf16* xr = x2 + (size_t)tok * DM + 8 * kq;
#pragma unroll
        for (int S = 0; S < 16; ++S) xpre[S] = *(const u32x4*)(xr + 32 * S); }
    { const u32x4* s = (const u32x4*)wrt; u32x4 tv[18];
#pragma unroll
      for (int j = 0; j < 18; ++j) tv[j] = s[F.tid + j * NTHR];
#pragma unroll
      for (int j = 0; j < 18; ++j) { const int i = F.tid + j * NTHR, row = i >> 7, c = i & 127; *(LAS u32x4*)(wl + row * RT_ROWB + c * 16) = tv[j]; } }
    for (int chunk = F.vcu; chunk < NTOK / 128; chunk += F.G) {
        if (F.tid < 32) hist[F.tid] = 0;
        __syncthreads();
        {
            const int tok0 = chunk * 128 + F.wave * 16, tok = tok0 + col;
            const float rstd = 1.f / sqrtf(ssq * (1.f / DM) + EPS);
            const bf16* xr = x2 + (size_t)tok * DM + 8 * kq; const LAS unsigned char* gr = g2l + 16 * kq; unsigned char* hr = H + (size_t)tok * DM + 8 * kq;
            const LAS unsigned char* w0 = wl + col * RT_ROWB + 16 * kq; const LAS unsigned char* w1 = wl + (16 + col) * RT_ROWB + 16 * kq; const LAS unsigned char* w2 = wl + (32 + (col & 3)) * RT_ROWB + 16 * kq;
            constexpr int LO = 36 * RT_ROWB;
            f32x4 a0 = {0.f, 0.f, 0.f, 0.f}, a1 = a0, a2 = a0;
            u32x4 xlate[16];
#pragma unroll
            for (int S = 0; S < 16; ++S) xlate[S] = *(const u32x4*)(xr + 32 * (16 + S));
#pragma unroll
            for (int S = 0; S < 16; ++S) {
                const u32x4 xv = xpre[S];
                const u32x4 gv = *(const LAS u32x4*)(gr + 64 * S);
                u32x2 hw; hw.x = pg8::pk4_fp8(bflo(xv.x) * bflo(gv.x) * rstd, bfhi(xv.x) * bfhi(gv.x) * rstd, bflo(xv.y) * bflo(gv.y) * rstd, bfhi(xv.y) * bfhi(gv.y) * rstd);
                hw.y = pg8::pk4_fp8(bflo(xv.z) * bflo(gv.z) * rstd, bfhi(xv.z) * bfhi(gv.z) * rstd, bflo(xv.w) * bflo(gv.w) * rstd, bfhi(xv.w) * bfhi(gv.w) * rstd);
                *(u32x2*)(hr + 32 * S) = hw;
                const bf16x8 av = __builtin_bit_cast(bf16x8, xv);
                const bf16x8 h0 = *(const LAS bf16x8*)(w0 + 64 * S), h1 = *(const LAS bf16x8*)(w1 + 64 * S), h2 = *(const LAS bf16x8*)(w2 + 64 * S);
                const bf16x8 l0 = *(const LAS bf16x8*)(w0 + LO + 64 * S), l1 = *(const LAS bf16x8*)(w1 + LO + 64 * S), l2 = *(const LAS bf16x8*)(w2 + LO + 64 * S);
                a0 = __builtin_amdgcn_mfma_f32_16x16x32_bf16(av, h0, a0, 0, 0, 0); a0 = __builtin_amdgcn_mfma_f32_16x16x32_bf16(av, l0, a0, 0, 0, 0);
                a1 = __builtin_amdgcn_mfma_f32_16x16x32_bf16(av, h1, a1, 0, 0, 0); a1 = __builtin_amdgcn_mfma_f32_16x16x32_bf16(av, l1, a1, 0, 0, 0);
                a2 = __builtin_amdgcn_mfma_f32_16x16x32_bf16(av, h2, a2, 0, 0, 0); a2 = __builtin_amdgcn_mfma_f32_16x16x32_bf16(av, l2, a2, 0, 0, 0);
            }
#pragma unroll
            for (int S = 16; S < 32; ++S) {
                const u32x4 xv = xlate[S - 16];
                const u32x4 gv = *(const LAS u32x4*)(gr + 64 * S);
                u32x2 hw; hw.x = pg8::pk4_fp8(bflo(xv.x) * bflo(gv.x) * rstd, bfhi(xv.x) * bfhi(gv.x) * rstd, bflo(xv.y) * bflo(gv.y) * rstd, bfhi(xv.y) * bfhi(gv.y) * rstd);
                hw.y = pg8::pk4_fp8(bflo(xv.z) * bflo(gv.z) * rstd, bfhi(xv.z) * bfhi(gv.z) * rstd, bflo(xv.w) * bflo(gv.w) * rstd, bfhi(xv.w) * bfhi(gv.w) * rstd);
                *(u32x2*)(hr + 32 * S) = hw;
                const bf16x8 av = __builtin_bit_cast(bf16x8, xv);
                const bf16x8 h0 = *(const LAS bf16x8*)(w0 + 64 * S), h1 = *(const LAS bf16x8*)(w1 + 64 * S), h2 = *(const LAS bf16x8*)(w2 + 64 * S);
                const bf16x8 l0 = *(const LAS bf16x8*)(w0 + LO + 64 * S), l1 = *(const LAS bf16x8*)(w1 + LO + 64 * S), l2 = *(const LAS bf16x8*)(w2 + LO + 64 * S);
                a0 = __builtin_amdgcn_mfma_f32_16x16x32_bf16(av, h0, a0, 0, 0, 0); a0 = __builtin_amdgcn_mfma_f32_16x16x32_bf16(av, l0, a0, 0, 0, 0);
                a1 = __builtin_amdgcn_mfma_f32_16x16x32_bf16(av, h1, a1, 0, 0, 0); a1 = __builtin_amdgcn_mfma_f32_16x16x32_bf16(av, l1, a1, 0, 0, 0);
                a2 = __builtin_amdgcn_mfma_f32_16x16x32_bf16(av, h2, a2, 0, 0, 0); a2 = __builtin_amdgcn_mfma_f32_16x16x32_bf16(av, l2, a2, 0, 0, 0);
            }
            { float rs[4];
#pragma unroll
              for (int e = 0; e < 4; ++e) rs[e] = __shfl(rstd, 4 * kq + e);
#pragma unroll
              for (int e = 0; e < 4; ++e) { a0[e] *= rs[e]; a1[e] *= rs[e]; a2[e] *= rs[e]; } }
            const int rowbase = lane & 48;
            const float bia0 = (col < 4) ? bgrp[col] : bexp[col - 4], bia1 = bexp[12 + col], bia2 = (col < 4) ? bexp[28 + col] : 0.f;
#pragma unroll
            for (int e = 0; e < 4; ++e) {
                const float x0 = a0[e] + bia0, x1 = a1[e] + bia1, x2v = a2[e] + bia2;
                const float l0 = __shfl(x0, rowbase), l1 = __shfl(x0, rowbase + 1), l2 = __shfl(x0, rowbase + 2), l3 = __shfl(x0, rowbase + 3);
                int gs = 0; float gm = l0; if (l1 > gm) { gm = l1; gs = 1; } if (l2 > gm) { gm = l2; gs = 2; } if (l3 > gm) { gm = l3; gs = 3; }
                const float wg = 1.f / (expf(l0 - gm) + expf(l1 - gm) + expf(l2 - gm) + expf(l3 - gm));
                int i0 = 0, i1 = -1; float v0 = -INFINITY, v1 = -INFINITY;
#pragma unroll
                for (int i = 0; i < 8; ++i) { const int c = 4 + 8 * gs + i, src = rowbase + (c & 15);
                    const float s0 = __shfl(x0, src), s1 = __shfl(x1, src), s2 = __shfl(x2v, src);
                    const float v = (c < 16) ? s0 : ((c < 32) ? s1 : s2);
                    if (v > v0) { v1 = v0; i1 = i0; v0 = v; i0 = i; } else if (v > v1) { v1 = v; i1 = i; } }
                const float p0 = 1.f / (1.f + expf(v1 - v0)), p1 = 1.f - p0;
                if (col == 0) { const int li = F.wave * 16 + 4 * kq + e, e0 = gs * 8 + i0, e1 = gs * 8 + i1;
                    sel_e[li * 2] = e0; sel_e[li * 2 + 1] = e1; sel_g[li * 2] = wg * p0; sel_g[li * 2 + 1] = wg * p1;
                    sel_r[li * 2] = atomicAdd((int*)&hist[e0], 1); sel_r[li * 2 + 1] = atomicAdd((int*)&hist[e1], 1); }
            }
        }
        __syncthreads();
        if (F.tid < 32) gbase[F.tid] = (int)atomicAdd(ctl + CW_CNT + 64 * F.tid, (unsigned)hist[F.tid]);
        __syncthreads();
        if (F.tid < 256) { const int li = F.tid >> 1, tok = chunk * 128 + li; const int e = sel_e[F.tid], pos = gbase[e] + sel_r[F.tid];
            tokl[e * LISTCAP + pos] = tok; gatel[e * LISTCAP + pos] = sel_g[F.tid]; slot[tok * 2 + (F.tid & 1)] = e * LISTCAP + pos; }
        if (chunk + F.G < NTOK / 128) { const int tok = (chunk + F.G) * 128 + F.wave * 16 + col; { float pv[16];
#pragma unroll
            for (int j = 0; j < 16; ++j) pv[j] = ss2[(size_t)j * NTOK + tok];
            ssq = (((pv[0] + pv[1]) + (pv[2] + pv[3])) + ((pv[4] + pv[5]) + (pv[6] + pv[7]))) + (((pv[8] + pv[9]) + (pv[10] + pv[11])) + ((pv[12] + pv[13]) + (pv[14] + pv[15]))); }
            const bf16* xr = x2 + (size_t)tok * DM + 8 * kq;
#pragma unroll
            for (int S = 0; S < 16; ++S) xpre[S] = *(const u32x4*)(xr + 32 * S); }
        __syncthreads();
    }
}

__device__ __forceinline__ int moe_tables(const Ctx& F) {
    LAS int* tab = (LAS int*)(F.lds + LDS_TAB); unsigned* ctl = (unsigned*)(F.ws + WS_CTL);
    LAS int* cnts = tab + 3 * MAXMT + 40;
    __syncthreads();
    if (F.tid < 32) cnts[F.tid] = (int)__hip_atomic_load(ctl + CW_CNT + 64 * F.tid, __ATOMIC_RELAXED, __HIP_MEMORY_SCOPE_AGENT);
    __syncthreads();
    if (F.tid == 0) { int mt = 0;
        for (int e = 0; e < NEXP; ++e) { const int c = cnts[e]; tab[3 * MAXMT + e] = mt * 256;
            for (int r = 0; r < c; r += 256) { tab[3 * mt] = e; tab[3 * mt + 1] = e * LISTCAP + r; tab[3 * mt + 2] = (c - r) < 256 ? (c - r) : 256; ++mt; } }
        tab[3 * MAXMT + 32] = mt; }
    __syncthreads();
    return tab[3 * MAXMT + 32];
}

__device__ __forceinline__ void final_phase(const Ctx& F, float* dst) {
    float* out = F.out; const unsigned char* Y = (const unsigned char*)(F.ws + WS_Y); const int* slot = (const int*)(F.ws + WS_SLOT); const float* gf = F.in[15];
    const LAS int* tab = (const LAS int*)(F.lds + LDS_TAB);
    const int gw = F.vcu * NWAVES + F.wave, NGW = F.G * NWAVES, lane = F.lane;
    f32x4 gv[4];
#pragma unroll
    for (int j = 0; j < 4; ++j) gv[j] = ((const f32x4*)gf)[lane + 64 * j];
    for (int tok = gw; tok < NTOK; tok += NGW) {
        const int s0 = slot[tok * 2], s1 = slot[tok * 2 + 1];
        const int r0 = tab[3 * MAXMT + (s0 >> 15)] + (s0 & (LISTCAP - 1)), r1 = tab[3 * MAXMT + (s1 >> 15)] + (s1 & (LISTCAP - 1));
        f32x4* xr = (f32x4*)(out + (size_t)tok * DM) + lane; const u32x2* x2r = (const u32x2*)((const bf16*)(F.ws + WS_H) + (size_t)tok * DM) + lane;
        const unsigned* y0 = (const unsigned*)(Y + (size_t)r0 * DM) + lane; const unsigned* y1 = (const unsigned*)(Y + (size_t)r1 * DM) + lane;
        f32x4 v[4]; float s = 0.f;
#pragma unroll
        for (int j = 0; j < 4; ++j) { const u32x2 xx = x2r[64 * j]; v[j] = (f32x4){bflo(xx.x), bfhi(xx.x), bflo(xx.y), bfhi(xx.y)}; const unsigned a = y0[64 * j], b = y1[64 * j];
            { const f32x2 a01 = __builtin_amdgcn_cvt_pk_f32_fp8((int)a, false), a23 = __builtin_amdgcn_cvt_pk_f32_fp8((int)a, true), b01 = __builtin_amdgcn_cvt_pk_f32_fp8((int)b, false), b23 = __builtin_amdgcn_cvt_pk_f32_fp8((int)b, true);
              v[j].x += (a01.x + b01.x) * 0.0625f; v[j].y += (a01.y + b01.y) * 0.0625f; v[j].z += (a23.x + b23.x) * 0.0625f; v[j].w += (a23.y + b23.y) * 0.0625f; }
            s += (v[j].x * v[j].x + v[j].y * v[j].y) + (v[j].z * v[j].z + v[j].w * v[j].w); }
        const float rstd = 1.f / sqrtf(wave_sum(s) * (1.f / DM) + EPS);
#pragma unroll
        for (int j = 0; j < 4; ++j) ((f32x4*)(dst + (size_t)tok * DM) + lane)[64 * j] = v[j] * rstd * gv[j];
    }
}

constexpr int NPHASE = 9;
struct Args { const float* in[16]; float* out; unsigned char* ws; int ph_lo, ph_hi; };
__global__ void __launch_bounds__(NTHR, 2) fwd(Args args) {
    extern __shared__ __attribute__((aligned(16))) unsigned char lds_raw[];
    Ctx F;
    F.lds = (LAS unsigned char*)lds_raw;
    F.tid = threadIdx.x; F.lane = F.tid & 63; F.wave = __builtin_amdgcn_readfirstlane(F.tid >> 6);
    F.G = gridDim.x; { const int bx = blockIdx.x; F.vcu = (F.G % 8 == 0) ? (bx % 8) * (F.G / 8) + bx / 8 : bx; }
#pragma unroll
    for (int i = 0; i < 16; ++i) F.in[i] = args.in[i];
    F.out = args.out; F.ws = args.ws;
    volatile LAS unsigned* MISC = (volatile LAS unsigned*)(F.lds + LDS_MISC);
    if (F.tid < 32) MISC[F.tid] = 0u;
    __syncthreads();
    unsigned* ctl = (unsigned*)(F.ws + WS_CTL);
#if MK_FUSED
    XcdBarrier bar = xcd_barrier_post(ctl + CW_BAR, MISC + 8);
#define GRID_BAR() xcd_barrier(bar)
#else
#define GRID_BAR() do {} while (0)
#endif
    const int lo = args.ph_lo, hi = args.ph_hi;
#define IN(k) (lo <= (k) && (k) < hi)
#define BOTH(k) (IN(k) && IN((k) + 1))
    LAS unsigned char* ring = F.lds;

    if (IN(0)) { p0_prologue(F); if (PROBE_DUP == 0) { GRID_BAR(); p0_prologue(F); } if (BOTH(0)) GRID_BAR(); }
    if (IN(1)) {
        pg8::PlainSched S; S.init(NTOK, NPROJ, DM, F.G, (int)blockIdx.x, F.ws + WS_WIN);
        pg8::EpiProj E{(bf16_t*)(F.ws + WS_PROJ), PPITCH, QSCALE, (const float*)(F.ws + WS_SUMSQ), (LAS float*)(F.lds + LDS_PRE)};
        pg8::gemm_phase<pg8::EpiProj, pg8::PlainSched, true>(ring, F.ws + WS_H, DM, S, E);
        if (PROBE_DUP == 1) { GRID_BAR(); pg8::gemm_phase<pg8::EpiProj, pg8::PlainSched, true>(ring, F.ws + WS_H, DM, S, E); }
        if (BOTH(1)) GRID_BAR();
    }
    if (IN(2)) { mixer_phase(F, 0); if (PROBE_DUP == 2) { GRID_BAR(); mixer_phase(F, 1024); } if (BOTH(2)) GRID_BAR(); }
    if (IN(4)) {
        pg8::PlainSched S; S.init(NTOK, DM, DM, F.G, (int)blockIdx.x, F.ws + WS_WOUT);
        LAS float* rtab = (LAS float*)(F.lds + LDS_TAB);
        { const float* sumsq = (const float*)(F.ws + WS_SUMSQ);
          for (int ui = 0; ui < 2; ++ui) { pg8::Unit u; if (!S.next(ui, u)) break;
              if (F.tid < 256) { const int tok = u.pm * 256 + F.tid; const float* sp = sumsq + (size_t)(tok >> 11) * 8 * SEQ + (tok & (SEQ - 1));
                  const float a0 = sp[0] + sp[SEQ], a1 = sp[2 * SEQ] + sp[3 * SEQ], a2 = sp[4 * SEQ] + sp[5 * SEQ], a3 = sp[6 * SEQ] + sp[7 * SEQ];
                  rtab[256 * ui + F.tid] = 1.f / sqrtf(((a0 + a1) + (a2 + a3)) * (1.f / 512.f) + EPS); } }
          __syncthreads(); }
        pg8::EpiRes E{(const bf16_t*)(F.ws + WS_H), (bf16_t*)(F.ws + WS_H), DM, (float*)(F.ws + WS_SSP), rtab};
                pg8::gemm_phase<pg8::EpiRes, pg8::PlainSched, true>(ring, F.ws + WS_MIX, DM, S, E);
        if (BOTH(4)) GRID_BAR();
    }
    if (IN(5)) { if (PROBE_DUP == 5) { route_mfma(F, true); GRID_BAR(); } route_mfma(F); if (BOTH(5)) GRID_BAR(); }
    if (IN(6)) {
        const int T = moe_tables(F);
        pg8::MoeSched<true> S; S.G = F.G; S.c = (int)blockIdx.x; S.T = T; S.K = DM / 2; S.tab = (const LAS int*)(F.lds + LDS_TAB); S.tokl = (const int*)(F.ws + WS_TOKL); S.W = (const char*)(F.ws + WS_WGU); S.wexp = (size_t)DM * DM;
        pg8::EpiGU E{(unsigned char*)(F.ws + WS_HID)};
        pg8::gemm_phase<pg8::EpiGU, pg8::MoeSched<true>, true, true>(ring, F.ws + WS_MIX, DM / 2, S, E);
        if (PROBE_DUP == 6) { GRID_BAR(); pg8::gemm_phase<pg8::EpiGU, pg8::MoeSched<true>, true, true>(ring, F.ws + WS_MIX, DM / 2, S, E); }
        {
            unsigned* q2 = (unsigned*)(F.ws + WS_CTL) + CW_Q + 128;
            for (;;) {
                __syncthreads();
                if (F.tid == 0) MISC[16] = __hip_atomic_fetch_add(q2, 1u, __ATOMIC_RELAXED, __HIP_MEMORY_SCOPE_AGENT);
                __syncthreads();
                const int id = (int)__builtin_amdgcn_readfirstlane(MISC[16]);
                if (id >= 256) break;
                LAS float* scr = (LAS float*)(F.lds + F.wave * 16384);
                for (int j = 0; j < 2; ++j) { const int t0 = 32 * id + 4 * F.wave + 2 * j;
                    moe_convert_pair(F, (t0 >> 8) * 768 + 512 + (t0 & 255), ((t0 + 1) >> 8) * 768 + 512 + ((t0 + 1) & 255), scr, F.lane); }
            }
        }
        if (BOTH(6)) GRID_BAR();
    }
    if (IN(7)) {
        const int T = moe_tables(F);
        pg8::MoeSched<false> S; S.G = F.G; S.c = (int)blockIdx.x; S.T = T; S.K = DEXP / 2; S.tab = (const LAS int*)(F.lds + LDS_TAB); S.tokl = nullptr; S.W = (const char*)(F.ws + WS_WD); S.wexp = (size_t)DM * DEXP;
        pg8::EpiDown E{(unsigned char*)(F.ws + WS_Y), (const float*)(F.ws + WS_GATEL), (LAS float*)(F.lds + LDS_PRE)};
        pg8::gemm_phase<pg8::EpiDown, pg8::MoeSched<false>, true, true>(ring, F.ws + WS_HID, DEXP / 2, S, E);
        if (PROBE_DUP == 7) { GRID_BAR(); pg8::gemm_phase<pg8::EpiDown, pg8::MoeSched<false>, true, true>(ring, F.ws + WS_HID, DEXP / 2, S, E); }
        if (BOTH(7)) GRID_BAR();
    }
    if (IN(8)) { (void)moe_tables(F); if (PROBE_DUP == 8) { final_phase(F, (float*)(F.ws + WS_MIX)); GRID_BAR(); } final_phase(F, F.out); }
#undef IN
#undef BOTH
}

extern "C" void kernel_launch(void* const* d_in, const int* in_sizes, int n_in, void* d_out, int out_size, void* d_ws, size_t ws_size, hipStream_t stream) {
    static int grid = 0;
    if (grid == 0) {
        if (n_in != 16 || out_size != NTOK * DM || ws_size < WS_END) { fprintf(stderr, "kernel_launch: unexpected shapes (n_in %d out %d ws %zu)\n", n_in, out_size, ws_size); grid = -1; return; }
        int dev = 0, cus = 0, per_cu = 0;
        if (hipGetDevice(&dev) != hipSuccess || hipDeviceGetAttribute(&cus, hipDeviceAttributeMultiprocessorCount, dev) != hipSuccess) { grid = -1; return; }
        if (hipFuncSetAttribute((const void*)fwd, hipFuncAttributeMaxDynamicSharedMemorySize, LDS_BYTES) != hipSuccess) { fprintf(stderr, "kernel_launch: hipFuncSetAttribute failed\n"); grid = -1; return; }
        if (hipOccupancyMaxActiveBlocksPerMultiprocessor(&per_cu, (const void*)fwd, NTHR, LDS_BYTES) != hipSuccess || per_cu < 1) fprintf(stderr, "kernel_launch: occupancy query reports %d\n", per_cu);
        (void)hipGetLastError();
        grid = cus;
    }
    if (grid < 0) return;
    (void)hipMemsetAsync((char*)d_ws + WS_CTL, 0, CTL_ZERO_BYTES, stream);
    Args a{};
    for (int i = 0; i < 16; ++i) a.in[i] = (const float*)d_in[i];
    a.out = (float*)d_out; a.ws = (unsigned char*)d_ws;
#if MK_FUSED
    a.ph_lo = 0; a.ph_hi = NPHASE;
    hipLaunchKernelGGL(fwd, dim3(grid), dim3(NTHR), LDS_BYTES, stream, a);
#else
    for (int p = 0; p < NPHASE; ++p) { a.ph_lo = p; a.ph_hi = p + 1; hipLaunchKernelGGL(fwd, dim3(grid), dim3(NTHR), LDS_BYTES, stream, a); }
#endif
}
```

```cpp
#include <hip/hip_runtime.h>
#include <cstdio>
#include <cstdint>

#ifndef PROBE_DUP
#define PROBE_DUP -1
#endif
#ifndef MK_FUSED
#define MK_FUSED 1
#endif

#define GAS __attribute__((address_space(1)))
#define LAS __attribute__((address_space(3)))
typedef unsigned short bf16;
typedef unsigned short bf16_t;
typedef short bf16x8 __attribute__((ext_vector_type(8)));
typedef float f32x4 __attribute__((ext_vector_type(4)));
typedef float f32x2 __attribute__((ext_vector_type(2)));
typedef unsigned u32x4 __attribute__((ext_vector_type(4)));
typedef unsigned u32x2 __attribute__((ext_vector_type(2)));
typedef GAS unsigned gu32;

constexpr int NWAVES = 8, NTHR = 512;
constexpr int NTOK = 32768, DM = 1024, SEQ = 2048, NBATCH = 16, NH = 8, HD = 64;
constexpr int NPROJ = 3584;
constexpr int PPITCH = 3712;
constexpr int POPITCH = 640;
constexpr int C_Q = 0, C_K = 512, C_V = 1024, C_HQ = 1536, C_HF = 2048, C_HI = 2560, C_HG = 3072;
constexpr int NEXP = 32, DEXP = 512, LISTCAP = 32768;
constexpr int MAXMT = 288, PROWS = MAXMT * 256;
constexpr float EPS = 1e-6f;
constexpr float LOG2E = 1.4426950408889634f;
constexpr float QSCALE = 0.125f * LOG2E;

constexpr size_t MiB = 1u << 20;
constexpr size_t WS_CTL = 0, CTL_ZERO_BYTES = 1 * MiB;
constexpr size_t WS_TOKL = 1 * MiB;
constexpr size_t WS_GATEL = 5 * MiB;
constexpr size_t WS_SLOT = 9 * MiB;
constexpr size_t WS_SUMSQ = 10 * MiB;
constexpr size_t WS_WRT = 11 * MiB;
constexpr size_t WS_WIN = 16 * MiB;
constexpr size_t WS_WOUT = 24 * MiB;
constexpr size_t WS_WGU = 32 * MiB;
constexpr size_t WS_WD = 96 * MiB;
constexpr size_t WS_H = 128 * MiB;
constexpr size_t WS_MIX = 192 * MiB;
constexpr size_t WS_PROJ = 256 * MiB;
constexpr size_t WS_HID = 256 * MiB;
constexpr size_t WS_Y = 328 * MiB;
constexpr size_t WS_END = 488 * MiB;
constexpr int CW_TMO = 0;
constexpr int CW_BAR = 4096;
constexpr int CW_CNT = 16384;
constexpr size_t WS_SSP = 12 * MiB;

constexpr int RING_BYTES = 131072;
constexpr int LDS_PHASE = 151552;
constexpr int LDS_TAB = LDS_PHASE;
constexpr int LDS_MISC = LDS_PHASE + 4096;
constexpr int LDS_WSCR = LDS_PHASE + 5120;
constexpr int LDS_BYTES = 163840;

__device__ __forceinline__ float bf2f(unsigned short u) { return __uint_as_float((unsigned)u << 16); }
__device__ __forceinline__ float bflo(unsigned u) { return __uint_as_float(u << 16); }
__device__ __forceinline__ float bfhi(unsigned u) { return __uint_as_float(u & 0xffff0000u); }
__device__ __forceinline__ unsigned f2bf(float f) { unsigned u = __builtin_bit_cast(unsigned, f); return (u + 0x7fffu + ((u >> 16) & 1u)) >> 16; }
__device__ __forceinline__ unsigned pk2(float lo, float hi) { return f2bf(lo) | (f2bf(hi) << 16); }
__device__ __forceinline__ float wave_sum(float v) {
#pragma unroll
    for (int o = 1; o < 64; o <<= 1) v += __shfl_xor(v, o);
    return v;
}
__device__ __forceinline__ float wave_max(float v) {
#pragma unroll
    for (int o = 1; o < 64; o <<= 1) v = fmaxf(v, __shfl_xor(v, o));
    return v;
}
#define LDS_WAIT() asm volatile("s_waitcnt lgkmcnt(0)" ::: "memory")
#define VM_WAIT() asm volatile("s_waitcnt vmcnt(0)" ::: "memory")

namespace pg8 {
#define PG8_LAS __attribute__((address_space(3)))
constexpr int BM = 256, BK = 64, HALF = 128, HTB = HALF * BK * 2, STAGE_BYTES = 8 * HTB, NXCD = 8, WGM = 8;
__host__ __device__ __forceinline__ int lds_byte(int r, int c) { const int st = (r >> 4) * 2 + (c >> 5), rr = r & 15, cc = c & 31, ob = rr * 64 + cc * 2; return st * 1024 + (ob ^ (((ob >> 9) & 1) << 5)); }
__host__ __device__ __forceinline__ void stage_rc(int b, int& R, int& C) { const int st = b / 1024, sb = b % 1024, swz = sb ^ (((sb >> 9) & 1) << 5); R = (st >> 1) * 16 + swz / 64; C = (st & 1) * 32 + (swz % 64) / 2; }
__host__ __device__ __forceinline__ int perm32(int rho) { const int n = rho >> 4, i = rho & 15; return 8 * (i >> 2) + 4 * n + (i & 3); }

struct Unit { int pm, pn, e, l0, cnt, mh; };

__device__ __forceinline__ unsigned cvt_pk_bf16(float lo, float hi) { unsigned r; asm volatile("v_cvt_pk_bf16_f32 %0, %1, %2" : "=v"(r) : "v"(lo), "v"(hi)); return r; }

struct PlainSched {
    int nM, nN, nwg, G, c, K; const char* Bt;
    __device__ void init(int M, int N, int K_, int G_, int c_, const void* Bt_) { nM = M / BM; nN = N / BM; nwg = nM * nN; G = G_; c = c_; K = K_; Bt = (const char*)Bt_; }
    __device__ __forceinline__ bool next(int i, Unit& u) const {
        const long L = (long)i * G + c; if (L >= nwg) return false;
        int wgid = (int)L; { const int q = nwg / NXCD, r = nwg % NXCD, xcd = wgid % NXCD, off = wgid / NXCD; wgid = (xcd < r ? xcd * (q + 1) : r * (q + 1) + (xcd - r) * q) + off; }
        const int nig = WGM * nN, gid = wgid / nig, fm = gid * WGM, gsz = (nM - fm) < WGM ? (nM - fm) : WGM;
        u.pm = fm + ((wgid % nig) % gsz); u.pn = (wgid % nig) / gsz; u.e = 0; u.l0 = 0; u.cnt = 256; u.mh = -1; return true;
    }
    __device__ __forceinline__ int a_row(const Unit& u, int r) const { return u.pm * BM + r; }
    __device__ __forceinline__ unsigned a_off2(const Unit&, int, int row) const { return (unsigned)row * (unsigned)(K * 2); }
    __device__ __forceinline__ const char* b_ptr(const Unit& u) const { return Bt + (size_t)u.pn * BM * K * 2; }
};
template <bool GATHER> struct MoeSched {
    int G, c, T, K; const PG8_LAS int* tab; const int* tokl; const char* W; size_t wexp;
    __device__ __forceinline__ bool next(int i, Unit& u) const {
        int mt, pn, mh = -1;
        if (G == 256) { const int R = T >> 6, rem = T & 63;
            if (i == R && rem <= 32) { const int m = c >> 3, sub = c & 7; if (m >= rem) return false; mt = 64 * R + m; pn = sub >> 1; mh = sub & 1; }
            else { const int x = c & 7, j = c >> 3; mt = i * 64 + x * 8 + (j >> 2); pn = j & 3; } }
        else { const int L = i * G + c; mt = L >> 2; pn = L & 3; }
        if (mt >= T) return false;
        int l0 = tab[3 * mt + 1], cnt = tab[3 * mt + 2];
        if (mh >= 0) { if (mh) { l0 += HALF; cnt -= HALF; } else cnt = cnt < HALF ? cnt : HALF; if (cnt <= 0) return false; }
        u.pm = mt; u.pn = pn; u.mh = mh; u.e = tab[3 * mt]; u.l0 = l0; u.cnt = cnt; return true;
    }
    __device__ __forceinline__ int a_row(const Unit& u, int r) const { if (GATHER) return tokl[u.l0 + ((r < u.cnt) ? r : 0)]; return u.pm * BM + (u.mh > 0 ? HALF : 0) + r; }
    __device__ __forceinline__ unsigned a_off2(const Unit& u, int r, int row) const { if (GATHER) return (r < u.cnt) ? (unsigned)row * (unsigned)(K * 2) : 0u; return (unsigned)row * (unsigned)(K * 2); }
    __device__ __forceinline__ const char* b_ptr(const Unit& u) const { return W + (size_t)u.e * wexp + (size_t)u.pn * BM * K * 2; }
};

struct EpiProj {
    static constexpr bool PERM = true, MIDSCALE = false;
    bf16_t* O; int ldc; float qscale; const float* rs1;
    __device__ __forceinline__ void operator()(const f32x4 (&acc)[2][2][4][2], const Unit& u, int wr, int wc, int fr, int fq) const {
        const int row0 = u.pm * BM + wr * 64 + fr, col0 = u.pn * BM + wc * 32 + 8 * fq;
        const float sc0 = (u.pn < 2) ? qscale : 1.f;
        float rsc[2][4];
#pragma unroll
        for (int ai = 0; ai < 2; ++ai)
#pragma unroll
            for (int m = 0; m < 4; ++m) rsc[ai][m] = rs1[row0 + ai * HALF + m * 16];
#pragma unroll
        for (int ai = 0; ai < 2; ++ai)
#pragma unroll
            for (int m = 0; m < 4; ++m) { bf16_t* rowp = O + (size_t)(row0 + ai * HALF + m * 16) * ldc + col0; const float sc = sc0 * rsc[ai][m];
#pragma unroll
                for (int bj = 0; bj < 2; ++bj) { const f32x4 v0 = acc[ai][bj][m][0] * sc, v1 = acc[ai][bj][m][1] * sc;
                    u32x4 w; w.x = cvt_pk_bf16(v0[0], v0[1]); w.y = cvt_pk_bf16(v0[2], v0[3]); w.z = cvt_pk_bf16(v1[0], v1[1]); w.w = cvt_pk_bf16(v1[2], v1[3]);
                    *(u32x4*)(rowp + bj * HALF) = w; } }
    }
};
struct EpiRes {
    static constexpr bool PERM = true, MIDSCALE = true;
    const bf16_t* base; bf16_t* out; int ldc; float* ss2; const PG8_LAS float* rtab;
    __device__ __forceinline__ void midscale(f32x4 (&acc)[2][2][4][2], int ui, int wr, int fr) const {
#pragma unroll
        for (int ai = 0; ai < 2; ++ai)
#pragma unroll
            for (int m = 0; m < 4; ++m) { const float s = rtab[256 * ui + ai * HALF + wr * 64 + m * 16 + fr];
#pragma unroll
                for (int bj = 0; bj < 2; ++bj)
#pragma unroll
                    for (int n = 0; n < 2; ++n) acc[ai][bj][m][n] = acc[ai][bj][m][n] * s; }
    }
    __device__ __forceinline__ void operator()(const f32x4 (&acc)[2][2][4][2], const Unit& u, int wr, int wc, int fr, int fq) const {
        const int row0 = u.pm * BM + wr * 64 + fr, col0 = u.pn * BM + wc * 32 + 8 * fq;
        u32x4 pre[2][4][2];
#pragma unroll
        for (int ai = 0; ai < 2; ++ai)
#pragma unroll
            for (int m = 0; m < 4; ++m) { const size_t off = (size_t)(row0 + ai * HALF + m * 16) * ldc + col0;
#pragma unroll
                for (int bj = 0; bj < 2; ++bj) pre[ai][m][bj] = *(const u32x4*)(base + off + bj * HALF); }
#pragma unroll
        for (int ai = 0; ai < 2; ++ai) {
#pragma unroll
            for (int m = 0; m < 4; ++m) { const int row = row0 + ai * HALF + m * 16; const size_t off = (size_t)row * ldc + col0; float ss = 0.f;
#pragma unroll
                for (int bj = 0; bj < 2; ++bj) { const u32x4 pb_ = pre[ai][m][bj]; const f32x4 b0 = (f32x4){bflo(pb_.x), bfhi(pb_.x), bflo(pb_.y), bfhi(pb_.y)}, b1 = (f32x4){bflo(pb_.z), bfhi(pb_.z), bflo(pb_.w), bfhi(pb_.w)};
                    const f32x4 o0 = b0 + acc[ai][bj][m][0], o1 = b1 + acc[ai][bj][m][1];
                    u32x4 w; w.x = cvt_pk_bf16(o0.x, o0.y); w.y = cvt_pk_bf16(o0.z, o0.w); w.z = cvt_pk_bf16(o1.x, o1.y); w.w = cvt_pk_bf16(o1.z, o1.w);
                    *(u32x4*)(out + off + bj * HALF) = w;
                    ss += (o0.x * o0.x + o0.y * o0.y) + (o0.z * o0.z + o0.w * o0.w) + (o1.x * o1.x + o1.y * o1.y) + (o1.z * o1.z + o1.w * o1.w); }
                ss += __shfl_xor(ss, 16); ss += __shfl_xor(ss, 32);
                if (fq == 0) ss2[(size_t)(u.pn * 4 + wc) * NTOK + row] = ss; } }
    }
};
__device__ __forceinline__ float silu_f(float g) { return g * __builtin_amdgcn_rcpf(1.f + __builtin_amdgcn_exp2f(-g * LOG2E)); }
__device__ __forceinline__ unsigned pk4_fp8(float a, float b, float c, float d) { int p = 0; p = __builtin_amdgcn_cvt_pk_fp8_f32(a, b, p, false); p = __builtin_amdgcn_cvt_pk_fp8_f32(c, d, p, true); return (unsigned)p; }
struct EpiGU {
    static constexpr bool PERM = true, MIDSCALE = false;
    unsigned char* Hd;
    __device__ __forceinline__ void operator()(const f32x4 (&acc)[2][2][4][2], const Unit& u, int wr, int wc, int fr, int fq) const {
        const int row0 = u.pm * BM + (u.mh > 0 ? HALF : 0) + wr * 64 + fr, col0 = u.pn * HALF + wc * 32 + 8 * fq;
#pragma unroll
        for (int ai = 0; ai < 2; ++ai) { if (ai == 1 && u.mh >= 0) continue;
#pragma unroll
            for (int m = 0; m < 4; ++m) { unsigned char* rowp = Hd + (size_t)(row0 + ai * HALF + m * 16) * DEXP + col0;
                const f32x4 g0 = acc[ai][0][m][0], g1 = acc[ai][0][m][1], u0 = acc[ai][1][m][0], u1 = acc[ai][1][m][1];
                u32x2 w; w.x = pk4_fp8(silu_f(g0[0]) * u0[0], silu_f(g0[1]) * u0[1], silu_f(g0[2]) * u0[2], silu_f(g0[3]) * u0[3]);
                w.y = pk4_fp8(silu_f(g1[0]) * u1[0], silu_f(g1[1]) * u1[1], silu_f(g1[2]) * u1[2], silu_f(g1[3]) * u1[3]);
                *(u32x2*)rowp = w; } }
    }
};
struct EpiDown {
    static constexpr bool PERM = true, MIDSCALE = false;
    unsigned char* Y; const float* gatel;
    __device__ __forceinline__ void operator()(const f32x4 (&acc)[2][2][4][2], const Unit& u, int wr, int wc, int fr, int fq) const {
        const int r0 = wr * 64 + fr, col0 = u.pn * BM + wc * 32 + 8 * fq;
        float gts[2][4];
#pragma unroll
        for (int ai = 0; ai < 2; ++ai)
#pragma unroll
            for (int m = 0; m < 4; ++m) { const int r = r0 + ai * HALF + m * 16; gts[ai][m] = gatel[u.l0 + ((r < u.cnt) ? r : 0)]; }
        asm volatile("" : "+v"(gts[0][0]), "+v"(gts[0][1]), "+v"(gts[0][2]), "+v"(gts[0][3]), "+v"(gts[1][0]), "+v"(gts[1][1]), "+v"(gts[1][2]), "+v"(gts[1][3]));
#pragma unroll
        for (int ai = 0; ai < 2; ++ai)
#pragma unroll
            for (int m = 0; m < 4; ++m) { const int r = r0 + ai * HALF + m * 16; gts[ai][m] = (r < u.cnt) ? 16.f * gts[ai][m] : 0.f; }
#pragma unroll
        for (int ai = 0; ai < 2; ++ai) { if (ai == 1 && u.mh >= 0) continue;
#pragma unroll
            for (int m = 0; m < 4; ++m) { const int r = r0 + ai * HALF + m * 16; const float gt = gts[ai][m];
                unsigned char* rowp = Y + (size_t)(u.pm * BM + (u.mh > 0 ? HALF : 0) + r) * DM + col0;
#pragma unroll
                for (int bj = 0; bj < 2; ++bj) { const f32x4 v0 = acc[ai][bj][m][0] * gt, v1 = acc[ai][bj][m][1] * gt;
                    u32x2 w; w.x = pk4_fp8(v0[0], v0[1], v0[2], v0[3]); w.y = pk4_fp8(v1[0], v1[1], v1[2], v1[3]);
                    *(u32x2*)(rowp + bj * HALF) = w; } } }
    }
};

typedef int v8i_t __attribute__((ext_vector_type(8)));
constexpr int FP8_SCALE_W = 0x7A7A7A7A, FP8_SCALE_X = 0x7F7F7F7F;

struct Frag16 { bf16x8 k[2]; };
__device__ __forceinline__ void ldfrag(Frag16& d, const PG8_LAS unsigned char* p) { d.k[0] = *(const PG8_LAS bf16x8*)p; d.k[1] = *(const PG8_LAS bf16x8*)(p + 1024); }
__device__ __forceinline__ void ldfrag(v8i_t& d, const PG8_LAS unsigned char* p) { typedef int v4i_t __attribute__((ext_vector_type(4))); const v4i_t lo = *(const PG8_LAS v4i_t*)p, hi = *(const PG8_LAS v4i_t*)(p + 16);
    d = __builtin_shufflevector(lo, hi, 0, 1, 2, 3, 4, 5, 6, 7); }
__device__ __forceinline__ void mmafrag(f32x4& c, const Frag16& b, const Frag16& a) { c = __builtin_amdgcn_mfma_f32_16x16x32_bf16(b.k[0], a.k[0], c, 0, 0, 0); c = __builtin_amdgcn_mfma_f32_16x16x32_bf16(b.k[1], a.k[1], c, 0, 0, 0); }
__device__ __forceinline__ void mmafrag(f32x4& c, const v8i_t& b, const v8i_t& a) {
    asm volatile("s_nop 1\n\tv_mfma_scale_f32_16x16x128_f8f6f4 %0, %1, %2, %0, %3, %4 op_sel_hi:[0,0,0]" : "+v"(c) : "v"(b), "v"(a), "v"(FP8_SCALE_W), "v"(FP8_SCALE_X)); }
template <bool FP8> struct FragT { typedef Frag16 T; };
template <> struct FragT<true> { typedef v8i_t T; };
template <class Epi, class Sched, bool ALIGN_EPI, bool FP8 = false>
__device__ __forceinline__ void gemm_phase(PG8_LAS unsigned char* lds, const void* Abase, const int K, const Sched& S, const Epi& E) {
    const int tid = threadIdx.x, wid = __builtin_amdgcn_readfirstlane(tid >> 6), lane = tid & 63, wr = wid >> 2, wc = wid & 3, fr = lane & 15, fq = lane >> 4;
    const int nt = K / BK;
    unsigned voffB[2];
#pragma unroll
    for (int i = 0; i < 2; ++i) { int R, C; stage_rc(tid * 16 + i * 8192, R, C); const int Rb = Epi::PERM ? ((R & ~31) + perm32(R & 31)) : R; voffB[i] = (unsigned)(Rb * K + C) * 2u; }
    const size_t kstep = (size_t)(BK * 2);
    const size_t hstepB = (size_t)HALF * K * 2;
    const unsigned ldsw = (unsigned)wid * 1024u;
    const int aoff = lds_byte(wr * 64 + fr, fq * (FP8 ? 16 : 8)), boff = lds_byte(wc * 32 + fr, fq * (FP8 ? 16 : 8));
#define PG8_SA(b, h) (((b) * 2 + (h)) * HTB)
#define PG8_SB(b, h) ((4 + (b) * 2 + (h)) * HTB)
#define PG8_STAGE(bufoff, gbase, voff) do { _Pragma("unroll") for (int _i = 0; _i < 2; ++_i) \
        __builtin_amdgcn_global_load_lds((const unsigned*)((const char*)(gbase) + (voff)[_i]), (PG8_LAS unsigned*)(lds + (bufoff) + ldsw + _i * 8192), 16, 0, 0); } while (0)
#define PG8_AOFF(dst, u) do { int t_[2][2]; _Pragma("unroll") for (int _i = 0; _i < 2; ++_i) { int R_, C_; stage_rc(tid * 16 + _i * 8192, R_, C_); \
        _Pragma("unroll") for (int _h = 0; _h < 2; ++_h) t_[_h][_i] = S.a_row(u, _h * HALF + R_); } \
        asm volatile("" : "+v"(t_[0][0]), "+v"(t_[0][1]), "+v"(t_[1][0]), "+v"(t_[1][1]));     \
        _Pragma("unroll") for (int _i = 0; _i < 2; ++_i) { int R_, C_; stage_rc(tid * 16 + _i * 8192, R_, C_); \
        _Pragma("unroll") for (int _h = 0; _h < 2; ++_h) dst[_h][_i] = S.a_off2(u, _h * HALF + R_, t_[_h][_i]) + (unsigned)C_ * 2u; } } while (0)
#define PG8_CAT8(lo, hi) __builtin_bit_cast(v8i_t, __builtin_shufflevector(lo, hi, 0, 1, 2, 3, 4, 5, 6, 7, 8, 9, 10, 11, 12, 13, 14, 15))
#define PG8_LDA(dst, b, h) do { _Pragma("unroll") for (int m = 0; m < 4; ++m) ldfrag(dst[m], lds + PG8_SA(b, h) + aoff + m * 2048); } while (0)
#define PG8_LDB(dst, b, h) do { _Pragma("unroll") for (int n = 0; n < 2; ++n) ldfrag(dst[n], lds + PG8_SB(b, h) + boff + n * 2048); } while (0)
#define PG8_MMA(ai, bj, At, Bt) do { __builtin_amdgcn_s_setprio(1); _Pragma("unroll") for (int m = 0; m < 4; ++m) _Pragma("unroll") for (int n = 0; n < 2; ++n) mmafrag(acc[ai][bj][m][n], Bt[n], At[m]); \
        __builtin_amdgcn_s_setprio(0); } while (0)
#define PG8_WAIT_V(n) asm volatile("s_waitcnt vmcnt(" #n ")" ::: "memory")
#define PG8_WAIT_L(n) asm volatile("s_waitcnt lgkmcnt(" #n ")" ::: "memory")
#define PG8_BAR __builtin_amdgcn_s_barrier()
#define PG8_SCHED __builtin_amdgcn_sched_barrier(0)
    Unit cur, nxt; int ui = 0;
    if (!S.next(0, cur)) return;
    f32x4 acc[2][2][4][2];
#pragma unroll
    for (int a = 0; a < 2; ++a)
#pragma unroll
        for (int b = 0; b < 2; ++b)
#pragma unroll
            for (int m = 0; m < 4; ++m)
#pragma unroll
                for (int n = 0; n < 2; ++n) acc[a][b][m][n] = (f32x4){0.f, 0.f, 0.f, 0.f};
    typename FragT<FP8>::T At[4], B0[2], B1[2];
    unsigned vC[2][2], vN[2][2];
    PG8_AOFF(vC, cur);
    const char* const Ab = (const char*)Abase;
    const char* cB = S.b_ptr(cur);
    PG8_STAGE(PG8_SB(0, 0), cB, voffB); PG8_STAGE(PG8_SB(0, 1), cB + hstepB, voffB); PG8_STAGE(PG8_SA(0, 0), Ab, vC[0]); PG8_STAGE(PG8_SA(0, 1), Ab, vC[1]);
    if (wr == 1) PG8_BAR;
    PG8_WAIT_V(2); PG8_BAR;
    PG8_STAGE(PG8_SB(1, 0), cB + kstep, voffB); PG8_STAGE(PG8_SA(1, 0), Ab + kstep, vC[0]); PG8_STAGE(PG8_SB(1, 1), cB + hstepB + kstep, voffB);
    PG8_WAIT_V(6); PG8_BAR;
    for (;;) {
        const bool has_next = S.next(ui + 1, nxt);
        const char* nB = has_next ? S.b_ptr(nxt) : cB;
        if (has_next) { PG8_AOFF(vN, nxt); }
        else {
#pragma unroll
            for (int h = 0; h < 2; ++h)
#pragma unroll
                for (int i = 0; i < 2; ++i) vN[h][i] = vC[h][i]; }
        const bool fullM = __builtin_amdgcn_readfirstlane(cur.mh) < 0;
        for (int t = 0; t < nt; t += 2) {
            if constexpr (Epi::MIDSCALE) { if (t == nt / 2) E.midscale(acc, ui, wr, fr); }
            const bool last = (t == nt - 2);
            const char* a1 = Ab + (size_t)(t + 1) * kstep;
            const char* a2 = last ? Ab : Ab + (size_t)(t + 2) * kstep; const char* b2 = last ? nB : cB + (size_t)(t + 2) * kstep;
            const char* a3 = a2 + kstep; const char* b3 = b2 + kstep;
            unsigned v2[2][2];
#pragma unroll
            for (int h = 0; h < 2; ++h)
#pragma unroll
                for (int i = 0; i < 2; ++i) v2[h][i] = last ? vN[h][i] : vC[h][i];
            PG8_LDB(B0, 0, 0); PG8_LDB(B1, 0, 1); PG8_SCHED; PG8_LDA(At, 0, 0); PG8_STAGE(PG8_SA(1, 1), a1, vC[1]);
            PG8_WAIT_V(8); PG8_WAIT_L(0); PG8_BAR; PG8_MMA(0, 0, At, B0); PG8_MMA(0, 1, At, B1); PG8_BAR; PG8_SCHED;
            if (fullM) { PG8_LDA(At, 0, 1); } PG8_STAGE(PG8_SB(0, 0), b2, voffB); PG8_STAGE(PG8_SB(0, 1), b2 + hstepB, voffB); PG8_STAGE(PG8_SA(0, 0), a2, v2[0]);
            PG8_WAIT_V(8); PG8_WAIT_L(0); PG8_BAR; if (fullM) { PG8_MMA(1, 0, At, B0); PG8_MMA(1, 1, At, B1); } PG8_BAR; PG8_SCHED;
            PG8_LDB(B0, 1, 0); PG8_LDB(B1, 1, 1); PG8_SCHED; PG8_LDA(At, 1, 0); PG8_STAGE(PG8_SA(0, 1), a2, v2[1]);
            PG8_WAIT_V(8); PG8_WAIT_L(0); PG8_BAR; PG8_MMA(0, 0, At, B0); PG8_MMA(0, 1, At, B1); PG8_BAR; PG8_SCHED;
            if (fullM) { PG8_LDA(At, 1, 1); } PG8_STAGE(PG8_SB(1, 0), b3, voffB); PG8_STAGE(PG8_SB(1, 1), b3 + hstepB, voffB); PG8_STAGE(PG8_SA(1, 0), a3, v2[0]);
            PG8_WAIT_V(8); PG8_WAIT_L(0); PG8_BAR; if (fullM) { PG8_MMA(1, 0, At, B0); PG8_MMA(1, 1, At, B1); } PG8_BAR; PG8_SCHED;
        }
        if constexpr (ALIGN_EPI) { if (wr == 0) PG8_BAR; }
        if constexpr (FP8) asm volatile("s_nop 15\n\ts_nop 15" ::: "memory");
        E(acc, cur, wr, wc, fr, fq);
        if (!has_next) break;
#pragma unroll
        for (int a = 0; a < 2; ++a)
#pragma unroll
            for (int b = 0; b < 2; ++b)
#pragma unroll
                for (int m = 0; m < 4; ++m)
#pragma unroll
                    for (int n = 0; n < 2; ++n) acc[a][b][m][n] = (f32x4){0.f, 0.f, 0.f, 0.f};
        cur = nxt; cB = nB; ++ui;
#pragma unroll
        for (int h = 0; h < 2; ++h)
#pragma unroll
            for (int i = 0; i < 2; ++i) vC[h][i] = vN[h][i];
        if constexpr (ALIGN_EPI) { if (wr == 1) PG8_BAR; }
    }
    PG8_WAIT_V(0);
    if constexpr (!ALIGN_EPI) { if (wr == 0) PG8_BAR; }
    PG8_BAR;
#undef PG8_SA
#undef PG8_SB
#undef PG8_STAGE
#undef PG8_AOFF
#undef PG8_LDA
#undef PG8_LDB
#undef PG8_MMA
#undef PG8_CAT8
#undef PG8_WAIT_V
#undef PG8_WAIT_L
#undef PG8_BAR
#undef PG8_SCHED
}
}

#define XB_TMO      128
#define XB_XCNT(j)  (256  + 64 * (j))
#define XB_XSUB(j)  (1280 + 64 * (j))
#define XB_XGEN(j)  (2304 + 64 * (j))
#define XB_TOP      3328
#define XB_TOPGEN   3392
#define XCD_BAR_WORDS 3456
#define XB_SPIN_CAP (1u << 18)
__device__ __forceinline__ unsigned xb_ld(unsigned* p)              { return __hip_atomic_load(p, __ATOMIC_RELAXED, __HIP_MEMORY_SCOPE_AGENT); }
__device__ __forceinline__ unsigned xb_add(unsigned* p, unsigned v) { return __hip_atomic_fetch_add(p, v, __ATOMIC_RELAXED, __HIP_MEMORY_SCOPE_AGENT); }
__device__ __forceinline__ unsigned xb_xcc_id() { return (unsigned)__builtin_amdgcn_s_getreg((3 << 11) | 20) & 0xFu; }
#define XB_SPIN(cond, bar) do { unsigned _sp = 0; while (cond) { __builtin_amdgcn_s_sleep(1); \
    if ((++_sp & 255u) == 0u) { if (xb_ld(&(bar)[XB_TMO])) break; if (_sp > XB_SPIN_CAP) { atomicAdd(&(bar)[XB_TMO], 1u); break; } } } } while (0)
struct XcdBarrier { unsigned* bar; unsigned x; volatile LAS unsigned* st; };
__device__ __forceinline__ XcdBarrier xcd_barrier_post(unsigned* bar, volatile LAS unsigned* st) {
    XcdBarrier b; b.bar = bar; b.x = xb_xcc_id(); b.st = st;
    if (threadIdx.x == 0) (void)xb_add(&bar[XB_XCNT(b.x)], 1u);
    return b;
}
__device__ __forceinline__ void xcd_barrier_complete(unsigned* bar, unsigned x, unsigned& nloc, unsigned& nx) {
    const unsigned G = gridDim.x * gridDim.y * gridDim.z;
    unsigned sum, cnt, mine, sp = 0u;
    for (;;) {
        sum = 0u; cnt = 0u; mine = 0u;
#pragma unroll
        for (unsigned j = 0; j < 16; ++j) { const unsigned c = xb_ld(&bar[XB_XCNT(j)]); sum += c; cnt += (c > 0u) ? 1u : 0u; mine = (j == x) ? c : mine; }
        if (sum == G) break;
        __builtin_amdgcn_s_sleep(1);
        if ((++sp & 255u) == 0u) { if (xb_ld(&bar[XB_TMO])) break; if (sp > XB_SPIN_CAP) { atomicAdd(&bar[XB_TMO], 1u); break; } }
    }
    nloc = mine > 0u ? mine : 1u; nx = cnt > 0u ? cnt : 1u;
}
__device__ __forceinline__ void xcd_barrier(const XcdBarrier& b) {
    asm volatile("s_waitcnt vmcnt(0)" ::: "memory");
    __syncthreads();
    if (threadIdx.x == 0) {
        unsigned* bar = b.bar;
        __builtin_amdgcn_s_waitcnt(0);
        unsigned nloc = b.st[0], nx = b.st[1];
        if (nloc == 0u) { xcd_barrier_complete(bar, b.x, nloc, nx); b.st[0] = nloc; b.st[1] = nx; }
        const unsigned old = xb_add(&bar[XB_XSUB(b.x)], 1u);
        const unsigned gen = old / nloc;
        if (old + 1u == (gen + 1u) * nloc) {
            __builtin_amdgcn_fence(__ATOMIC_RELEASE, "agent");
            asm volatile("s_waitcnt vmcnt(0)" ::: "memory");
            const unsigned og = xb_add(&bar[XB_TOP], 1u);
            const unsigned tg = og / nx;
            if (og + 1u == (tg + 1u) * nx) xb_add(&bar[XB_TOPGEN], 1u);
            else XB_SPIN(xb_ld(&bar[XB_TOPGEN]) == tg, bar);
            __builtin_amdgcn_fence(__ATOMIC_ACQUIRE, "agent");
            xb_add(&bar[XB_XGEN(b.x)], 1u);
            asm volatile("s_waitcnt vmcnt(0)" ::: "memory");
        } else {
            XB_SPIN(xb_ld(&bar[XB_XGEN(b.x)]) == gen, bar);
            __builtin_amdgcn_fence(__ATOMIC_ACQUIRE, "agent");
            asm volatile("s_waitcnt vmcnt(0)" ::: "memory");
        }
    }
    __syncthreads();
}

struct Ctx {
    LAS unsigned char* lds; int tid, lane, wave, vcu, G;
    const float* in[16]; float* out; unsigned char* ws;
};

__device__ __forceinline__ void p0_transpose_item(const float* W, int K, int N, bf16* WT, int k0, int n0, int drow0, LAS float* scr, int lane, const float* kgain = nullptr) {
    const int kr = lane >> 3, c4 = lane & 7;
    f32x4 w[8];
#pragma unroll
    for (int i = 0; i < 8; ++i) w[i] = *(const f32x4*)(W + (size_t)(k0 + kr + 8 * i) * N + n0 + 4 * c4);
    if (kgain) {
#pragma unroll
        for (int i = 0; i < 8; ++i) w[i] = w[i] * kgain[k0 + kr + 8 * i]; }
#pragma unroll
    for (int i = 0; i < 8; ++i) { LAS float* d = scr + (kr + 8 * i) * 33 + 4 * c4; d[0] = w[i].x; d[1] = w[i].y; d[2] = w[i].z; d[3] = w[i].w; }
    LDS_WAIT(); asm volatile("" ::: "memory");
    const int c = lane & 7;
#pragma unroll
    for (int j = 0; j < 4; ++j) { const int n = (lane >> 3) + 8 * j; const LAS float* s = scr + (8 * c) * 33 + n;
        u32x4 o; o.x = pk2(s[0 * 33], s[1 * 33]); o.y = pk2(s[2 * 33], s[3 * 33]); o.z = pk2(s[4 * 33], s[5 * 33]); o.w = pk2(s[6 * 33], s[7 * 33]);
        *(GAS u32x4*)(WT + (size_t)(drow0 + n) * K + k0 + 8 * c) = o; }
    LDS_WAIT(); asm volatile("" ::: "memory");
}
__device__ __forceinline__ void p0_transpose_item_fp8(const float* W, int K, int N, unsigned char* WT, int k0, int n0, int drow0, LAS float* scr, int lane) {
    const int kr = lane >> 3, c4 = lane & 7;
    f32x4 w[8];
#pragma unroll
    for (int i = 0; i < 8; ++i) w[i] = *(const f32x4*)(W + (size_t)(k0 + kr + 8 * i) * N + n0 + 4 * c4);
#pragma unroll
    for (int i = 0; i < 8; ++i) { LAS float* d = scr + (kr + 8 * i) * 33 + 4 * c4; d[0] = w[i].x * 32.f; d[1] = w[i].y * 32.f; d[2] = w[i].z * 32.f; d[3] = w[i].w * 32.f; }
    LDS_WAIT(); asm volatile("" ::: "memory");
    const int q = lane & 3;
#pragma unroll
    for (int j = 0; j < 2; ++j) { const int n = (lane >> 2) + 16 * j; const LAS float* s = scr + (16 * q) * 33 + n;
        u32x4 o; o.x = pg8::pk4_fp8(s[0 * 33], s[1 * 33], s[2 * 33], s[3 * 33]); o.y = pg8::pk4_fp8(s[4 * 33], s[5 * 33], s[6 * 33], s[7 * 33]);
        o.z = pg8::pk4_fp8(s[8 * 33], s[9 * 33], s[10 * 33], s[11 * 33]); o.w = pg8::pk4_fp8(s[12 * 33], s[13 * 33], s[14 * 33], s[15 * 33]);
        *(GAS u32x4*)(WT + (size_t)(drow0 + n) * K + k0 + 16 * q) = o; }
    LDS_WAIT(); asm volatile("" ::: "memory");
}
struct ConvItem { const float* W; unsigned char* WT; int K, N, k0, n0, drow0; };
__device__ __forceinline__ ConvItem moe_conv_desc(const Ctx& F, int r) {
    unsigned char* ws = F.ws; ConvItem c; const int e = r / 768; r -= e * 768;
    if (r < 256) { const int kb = r / 16, nb = r % 16, n0 = 32 * nb; c.W = F.in[12] + (size_t)e * DM * DEXP; c.WT = (unsigned char*)(ws + WS_WGU) + (size_t)e * DM * DM; c.K = DM; c.N = DEXP; c.k0 = 64 * kb; c.n0 = n0; c.drow0 = (n0 >> 7) * 256 + (n0 & 127); return c; } r -= 256;
    if (r < 256) { const int kb = r / 16, nb = r % 16, n0 = 32 * nb; c.W = F.in[13] + (size_t)e * DM * DEXP; c.WT = (unsigned char*)(ws + WS_WGU) + (size_t)e * DM * DM; c.K = DM; c.N = DEXP; c.k0 = 64 * kb; c.n0 = n0; c.drow0 = (n0 >> 7) * 256 + 128 + (n0 & 127); return c; } r -= 256;
    { const int kb = r / 32, nb = r % 32; c.W = F.in[14] + (size_t)e * DEXP * DM; c.WT = (unsigned char*)(ws + WS_WD) + (size_t)e * DM * DEXP; c.K = DEXP; c.N = DM; c.k0 = 64 * kb; c.n0 = 32 * nb; c.drow0 = 32 * nb; return c; }
}
__device__ __forceinline__ void moe_convert_pair(const Ctx& F, int r0, int r1, LAS float* scr, int lane_in) {
    int lane = lane_in; asm volatile("" : "+v"(lane));
    const ConvItem a = moe_conv_desc(F, r0), b = moe_conv_desc(F, r1);
    const int kr = lane >> 3, c4 = lane & 7;
    f32x4 wa[8], wb[8];
#pragma unroll
    for (int i = 0; i < 8; ++i) wa[i] = *(const f32x4*)(a.W + (size_t)(a.k0 + kr + 8 * i) * a.N + a.n0 + 4 * c4);
#pragma unroll
    for (int i = 0; i < 8; ++i) wb[i] = *(const f32x4*)(b.W + (size_t)(b.k0 + kr + 8 * i) * b.N + b.n0 + 4 * c4);
#pragma unroll
    for (int half = 0; half < 2; ++half) {
        const ConvItem& c = half ? b : a;
#pragma unroll
        for (int i = 0; i < 8; ++i) { const f32x4 w = half ? wb[i] : wa[i]; LAS float* d = scr + (kr + 8 * i) * 33 + 4 * c4; d[0] = w.x * 32.f; d[1] = w.y * 32.f; d[2] = w.z * 32.f; d[3] = w.w * 32.f; }
        LDS_WAIT(); asm volatile("" ::: "memory");
        const int q = lane & 3;
#pragma unroll
        for (int j = 0; j < 2; ++j) { const int n = (lane >> 2) + 16 * j; const LAS float* s = scr + (16 * q) * 33 + n;
            u32x4 o; o.x = pg8::pk4_fp8(s[0 * 33], s[1 * 33], s[2 * 33], s[3 * 33]); o.y = pg8::pk4_fp8(s[4 * 33], s[5 * 33], s[6 * 33], s[7 * 33]);
            o.z = pg8::pk4_fp8(s[8 * 33], s[9 * 33], s[10 * 33], s[11 * 33]); o.w = pg8::pk4_fp8(s[12 * 33], s[13 * 33], s[14 * 33], s[15 * 33]);
            *(GAS u32x4*)(c.WT + (size_t)(c.drow0 + n) * c.K + c.k0 + 16 * q) = o; }
        LDS_WAIT(); asm volatile("" ::: "memory");
    }
}
__device__ __forceinline__ void p0_prologue(const Ctx& F) {
    LAS float* scr = (LAS float*)(F.lds + F.wave * 16384);
    const int gw = F.vcu * NWAVES + F.wave, NGW = F.G * NWAVES;
    unsigned char* ws = F.ws;
    constexpr int I_IN = 16 * 112, I_OUT = 16 * 32, NITEMS = I_IN + I_OUT;
    for (int it = gw; it < NITEMS; it += NGW) {
        int r = it;
        if (r < I_IN) { const int kb = r / 112, nb = r % 112; p0_transpose_item(F.in[2], DM, NPROJ, (bf16*)(ws + WS_WIN), 64 * kb, 32 * nb, 32 * nb, scr, F.lane, F.in[1]); continue; } r -= I_IN;
        { const int kb = r / 32, nb = r % 32; p0_transpose_item(F.in[6], DM, DM, (bf16*)(ws + WS_WOUT), 64 * kb, 32 * nb, 32 * nb, scr, F.lane, kb < 8 ? F.in[3] : nullptr); }
    }
    { bf16* whi = (bf16*)(ws + WS_WRT); bf16* wlo = whi + 36 * DM; const int gt = F.vcu * NTHR + F.tid, NGT = F.G * NTHR;
      for (int idx = gt; idx < 36 * DM; idx += NGT) { const int o = idx / DM, k = idx % DM; const float w = F.in[7][k] * ((o < 4) ? F.in[8][k * 4 + o] : F.in[10][k * 32 + (o - 4)]);
          const unsigned h = f2bf(w); whi[idx] = (bf16)h; wlo[idx] = (bf16)f2bf(w - __uint_as_float(h << 16)); } }
    const float* x = F.in[0]; bf16* H = (bf16*)(ws + WS_H); float* rs1 = (float*)(ws + WS_SUMSQ);
    for (int m = gw; m < NTOK; m += NGW) {
        const GAS f32x4* xr = (const GAS f32x4*)(x + (size_t)m * DM) + F.lane;
        f32x4 v[4]; float s = 0.f;
#pragma unroll
        for (int j = 0; j < 4; ++j) { v[j] = xr[64 * j]; s += (v[j].x * v[j].x + v[j].y * v[j].y) + (v[j].z * v[j].z + v[j].w * v[j].w); }
        const float rstd = 1.f / sqrtf(wave_sum(s) * (1.f / DM) + EPS);
        if (F.lane == 0) rs1[m] = rstd;
        GAS unsigned long long* o8 = (GAS unsigned long long*)(H + (size_t)m * DM) + F.lane;
#pragma unroll
        for (int j = 0; j < 4; ++j) o8[64 * j] = (unsigned long long)pk2(v[j].x, v[j].y) | ((unsigned long long)pk2(v[j].z, v[j].w) << 32);
    }
}

namespace att {
typedef float f32x16 __attribute__((ext_vector_type(16)));
typedef short s16x4 __attribute__((ext_vector_type(4)));
typedef short v4i16_t __attribute__((ext_vector_type(4)));
typedef __attribute__((address_space(3))) const char* lds_cptr;
constexpr float NEGBIG = -1.0e30f, THR = 12.f;
__device__ __forceinline__ void glds16(const void* gsrc, unsigned lds_dst) { unsigned keep;
    asm volatile("s_mov_b32 %0, m0\n\ts_mov_b32 m0, %2\n\ts_nop 0\n\tglobal_load_lds_dwordx4 %1, off\n\ts_mov_b32 m0, %0" : "=&s"(keep) : "v"(gsrc), "s"(lds_dst) : "memory"); }
__device__ __forceinline__ s16x4 vtr(lds_cptr p) { return __builtin_bit_cast(s16x4, __builtin_amdgcn_ds_read_tr16_b64_v4i16((__attribute__((address_space(3))) v4i16_t*)p)); }
__device__ __forceinline__ float xmax32(float m) { auto rr = __builtin_amdgcn_permlane32_swap(__float_as_uint(m), __float_as_uint(m), false, false); return fmaxf(__uint_as_float(rr[0]), __uint_as_float(rr[1])); }
__device__ __forceinline__ float xsum32(float m) { auto rr = __builtin_amdgcn_permlane32_swap(__float_as_uint(m), __float_as_uint(m), false, false); return __uint_as_float(rr[0]) + __uint_as_float(rr[1]); }
__device__ __forceinline__ unsigned cvtpk(float lo, float hi) { typedef float f2 __attribute__((ext_vector_type(2))); typedef __bf16 b2 __attribute__((ext_vector_type(2))); f2 v = {lo, hi}; b2 b = __builtin_convertvector(v, b2); return __builtin_bit_cast(unsigned, b); }

struct Bufs { const bf16* proj; bf16* po16; float* pl16; bf16* po4; float* pl4; bf16* mix; float* sumsq; };

struct KVAddr { const char* kb0; const char* kb1; const char* vbp; size_t pstep, tstep; };
__device__ __forceinline__ KVAddr kv_addr(const char* pb, int h, int d, int r, int lane) {
    const size_t rowB = (size_t)PPITCH * 2; const int kl8 = lane >> 3, sw = lane >> 4; KVAddr A;
    const char* rowp = pb + (size_t)(kl8 * d + r) * rowB;
    A.kb0 = rowp + (C_K + h * 64) * 2 + (((lane & 7) ^ sw) * 16);
    A.kb1 = rowp + (C_K + h * 64) * 2 + (((lane & 7) ^ (4 + sw)) * 16);
    A.vbp = rowp + (C_V + h * 64) * 2 + (((lane & 7) ^ ((sw & 1) << 2)) * 16);
    A.pstep = (size_t)8 * d * rowB; A.tstep = (size_t)32 * d * rowB; return A; }
__device__ __forceinline__ void kv_dma(const KVAddr& A, int kt, unsigned lb_) {
    const size_t to_ = (size_t)kt * A.tstep;
    glds16(A.kb0 + to_, (unsigned)__builtin_amdgcn_readfirstlane(lb_)); glds16(A.kb1 + to_ + A.pstep, (unsigned)__builtin_amdgcn_readfirstlane(lb_ + 1024u));
    glds16(A.kb0 + to_ + 2 * A.pstep, (unsigned)__builtin_amdgcn_readfirstlane(lb_ + 2048u)); glds16(A.kb1 + to_ + 3 * A.pstep, (unsigned)__builtin_amdgcn_readfirstlane(lb_ + 3072u));
    glds16(A.vbp + to_, (unsigned)__builtin_amdgcn_readfirstlane(lb_ + 4096u)); glds16(A.vbp + to_ + A.pstep, (unsigned)__builtin_amdgcn_readfirstlane(lb_ + 5120u));
    glds16(A.vbp + to_ + 2 * A.pstep, (unsigned)__builtin_amdgcn_readfirstlane(lb_ + 6144u)); glds16(A.vbp + to_ + 3 * A.pstep, (unsigned)__builtin_amdgcn_readfirstlane(lb_ + 7168u)); }

template <int NQ> struct QPre { u32x4 qv[NQ][4]; };
__device__ __forceinline__ void prolog_dma(const Bufs& B, unsigned wl_addr, int b, int h, int d, int r, int u0, int lane_in, int slot) {
    int lane = lane_in; asm volatile("" : "+v"(lane));
    const size_t rowB = (size_t)PPITCH * 2; const char* pb = (const char*)B.proj + (size_t)b * SEQ * rowB;
    const KVAddr A = kv_addr(pb, h, d, r, lane);
    const int jA = u0 >> 5; const int kt0 = (jA - 4) > 0 ? (jA - 4) : 0;
    kv_dma(A, kt0, wl_addr + (unsigned)slot * 8192u);
}
template <int NQ>
__device__ __forceinline__ void prolog_q(const Bufs& B, int b, int h, int d, int r, int u0, int lane_in, QPre<NQ>& P) {
    int lane = lane_in; asm volatile("" : "+v"(lane));
    const size_t rowB = (size_t)PPITCH * 2; const char* pb = (const char*)B.proj + (size_t)b * SEQ * rowB;
    const int kl8 = lane >> 3;
#pragma unroll
    for (int x = 0; x < NQ; ++x)
#pragma unroll
        for (int p = 0; p < 4; ++p) P.qv[x][p] = *(const u32x4*)(pb + (size_t)((u0 + 32 * x + 8 * p + kl8) * d + r) * rowB + (C_Q + h * 64) * 2 + (lane & 7) * 16);
}
struct NoNext { static constexpr int NOPS = 0; __device__ __forceinline__ void dma(int) const {} __device__ __forceinline__ void qload() const {} };
template <int NQN> struct NextPro { const Bufs& B; unsigned wl_addr; int b, h, d, r, u0, lane; QPre<NQN>& P; static constexpr int NOPS = 8;
    __device__ __forceinline__ void dma(int slot) const { prolog_dma(B, wl_addr, b, h, d, r, u0, lane, slot); }
    __device__ __forceinline__ void qload() const { prolog_q<NQN>(B, b, h, d, r, u0, lane, P); } };

template <int NQ> struct Stash { u32x4 v[NQ][4]; float lse[NQ]; };
struct NoFlush { static constexpr int NST = 0; __device__ __forceinline__ void operator()() const {} };
template <int NQP> struct Flush { bf16* po; float* pl; int b, h, d, r, u0, lane; const Stash<NQP>& S; static constexpr int NST = 5 * NQP;
    __device__ __forceinline__ void operator()() const {
        int ln = lane; asm volatile("" : "+v"(ln));
        const int kl8 = ln >> 3, ch = ln & 7, i = ln & 31, hi = ln >> 5;
#pragma unroll
        for (int x = 0; x < NQP; ++x) {
#pragma unroll
            for (int p = 0; p < 4; ++p) { const int tokr = b * SEQ + (u0 + 32 * x + 8 * p + kl8) * d + r; *(u32x4*)(po + (size_t)tokr * POPITCH + h * 64 + ch * 8) = S.v[x][p]; }
            if (hi == 0) pl[(b * 8 + h) * SEQ + r * (SEQ / d) + u0 + 32 * x + i] = S.lse[x]; }
    } };

template <int NQ, int MODE, class Prev, class Next>
__device__ __forceinline__ int qgroup(const Bufs& B, lds_cptr wl, unsigned wl_addr, int b, int h, int d, int r, int u0, float slope2, int lane_in, QPre<NQ>& P, int s0, const Prev& prev, const Next& next, Stash<NQ>& out) {
    int lane = lane_in; asm volatile("" : "+v"(lane));
    constexpr int NST = Prev::NST;
    const int i = lane & 31, hi = lane >> 5;
    const size_t rowB = (size_t)PPITCH * 2;
    const char* pb = (const char*)B.proj + (size_t)b * SEQ * rowB;
    const float sld = slope2 * (float)d; const int iq = i - 4 * hi; const float bl = -sld * (float)(iq + 128);
    const int kl8 = lane >> 3, sw = lane >> 4;
    const KVAddr A = kv_addr(pb, h, d, r, lane);
    const int ksw = (i >> 1) & 7;
    int kaddr[4];
#pragma unroll
    for (int s = 0; s < 4; ++s) kaddr[s] = i * 128 + (((2 * s + hi) ^ ksw) * 16);
    const int g16 = lane >> 4, i16 = lane & 15, kbit = (i16 >> 3) & 1, vrow = 4 * hi + (i16 >> 2), vcol = 2 * (g16 & 1) + ((i16 & 3) >> 1), vb8 = (i16 & 1) * 8;
    const int va0 = 4096 + vrow * 128 + (vcol + 4 * kbit) * 16 + vb8, va1 = 4096 + vrow * 128 + (vcol + 4 * (1 - kbit)) * 16 + vb8;
    const int jA = u0 >> 5; const int kt0 = (jA - 4) > 0 ? (jA - 4) : 0, kt1 = jA + NQ - 1;
    f32x16 O[NQ][2]; float lsum[NQ], mrun[NQ];
#pragma unroll
    for (int x = 0; x < NQ; ++x) { lsum[x] = 0.f; mrun[x] = 0.f;
#pragma unroll
        for (int e = 0; e < 16; ++e) { O[x][0][e] = 0.f; O[x][1][e] = 0.f; } }
    bf16x8 qf[NQ][4];
    { typedef __attribute__((address_space(3))) unsigned char* lds_pq; const lds_pq qs = (lds_pq)wl + (s0 ^ 1) * 8192;
#pragma unroll
      for (int x = 0; x < NQ; ++x)
#pragma unroll
          for (int p = 0; p < 4; ++p) *(__attribute__((address_space(3))) u32x4*)(qs + x * 4096 + (8 * p + kl8) * 128 + (((lane & 7) ^ (4 * (p & 1) + sw)) * 16)) = P.qv[x][p];
      asm volatile("s_waitcnt lgkmcnt(0)" ::: "memory"); __builtin_amdgcn_wave_barrier();
#pragma unroll
      for (int x = 0; x < NQ; ++x)
#pragma unroll
          for (int s = 0; s < 4; ++s) qf[x][s] = *(const __attribute__((address_space(3))) bf16x8*)(qs + x * 4096 + kaddr[s]);
      asm volatile("s_waitcnt lgkmcnt(0)" ::: "memory"); __builtin_amdgcn_wave_barrier(); }
    if (kt0 < kt1) kv_dma(A, kt0 + 1, wl_addr + (unsigned)(s0 ^ 1) * 8192u); else next.dma(s0 ^ 1);
    prev();
    for (int kt = kt0; kt <= kt1; ++kt) {
        const int slot = ((kt - kt0) & 1) ^ s0;
        if (kt > kt0) { if (kt < kt1) kv_dma(A, kt + 1, wl_addr + (unsigned)(slot ^ 1) * 8192u); else next.dma(slot ^ 1); }
        if (kt < kt1 || Next::NOPS == 8) { if (kt - kt0 < 2) asm volatile("s_waitcnt vmcnt(%0)" :: "n"(8 + NST) : "memory"); else asm volatile("s_waitcnt vmcnt(8)" ::: "memory"); }
        else { if (kt - kt0 < 2) asm volatile("s_waitcnt vmcnt(%0)" :: "n"(NST) : "memory"); else asm volatile("s_waitcnt vmcnt(0)" ::: "memory"); }
        const lds_cptr sl = wl + slot * 8192;
        bf16x8 kf[4];
#pragma unroll
        for (int s = 0; s < 4; ++s) kf[s] = *(const __attribute__((address_space(3))) bf16x8*)(sl + kaddr[s]);
        bf16x8 vf[2][2];
#pragma unroll
        for (int ks = 0; ks < 2; ++ks) {
            const s16x4 a0 = vtr(sl + va0 + 2048 * ks), a1 = vtr(sl + va0 + 2048 * ks + 1024), b0 = vtr(sl + va1 + 2048 * ks), b1 = vtr(sl + va1 + 2048 * ks + 1024);
            vf[0][ks] = (bf16x8){a0[0], a0[1], a0[2], a0[3], a1[0], a1[1], a1[2], a1[3]};
            vf[1][ks] = (bf16x8){b0[0], b0[1], b0[2], b0[3], b1[0], b1[1], b1[2], b1[3]}; }
#pragma unroll
        for (int x = 0; x < NQ; ++x) {
            const int c = kt - (jA + x - 4);
            if (c >= 0 && c <= 4) {
                const int ktf = (jA + x - 4) > 0 ? (jA + x - 4) : 0;
                const bool first = (kt == ktf);
                const float base = bl + sld * (float)(32 * c) - (first ? 0.f : mrun[x]);
                f32x16 S;
#pragma unroll
                for (int e = 0; e < 16; ++e) S[e] = base + sld * (float)((e & 3) + 8 * (e >> 2));
                if (c == 0) {
#pragma unroll
                    for (int e = 0; e < 16; ++e) S[e] = (((e & 3) + 8 * (e >> 2)) >= iq) ? S[e] : NEGBIG; }
                if (c == 4) {
#pragma unroll
                    for (int e = 0; e < 16; ++e) S[e] = (((e & 3) + 8 * (e >> 2)) <= iq) ? S[e] : NEGBIG; }
#pragma unroll
                for (int s = 0; s < 4; ++s) S = __builtin_amdgcn_mfma_f32_32x32x16_bf16(kf[s], qf[x][s], S, 0, 0, 0);
                float mx = fmaxf(fmaxf(S[0], S[1]), fmaxf(S[2], S[3]));
#pragma unroll
                for (int e = 4; e < 16; e += 4) mx = fmaxf(mx, fmaxf(fmaxf(S[e], S[e + 1]), fmaxf(S[e + 2], S[e + 3])));
                mx = xmax32(mx);
                if (first) { mrun[x] = mx;
#pragma unroll
                    for (int e = 0; e < 16; ++e) S[e] -= mx; }
                else if (__any(mx > THR)) { const float dl = fmaxf(mx, 0.f); mrun[x] += dl; const float al = __builtin_amdgcn_exp2f(-dl); lsum[x] *= al;
#pragma unroll
                    for (int e = 0; e < 16; ++e) { S[e] -= dl; O[x][0][e] *= al; O[x][1][e] *= al; } }
                float ps = 0.f;
#pragma unroll
                for (int e = 0; e < 16; ++e) { S[e] = __builtin_amdgcn_exp2f(S[e]); ps += S[e]; }
                lsum[x] += ps;
                u32x4 w0, w1;
                w0.x = cvtpk(S[0], S[1]); w0.y = cvtpk(S[2], S[3]); w0.z = cvtpk(S[4], S[5]); w0.w = cvtpk(S[6], S[7]);
                w1.x = cvtpk(S[8], S[9]); w1.y = cvtpk(S[10], S[11]); w1.z = cvtpk(S[12], S[13]); w1.w = cvtpk(S[14], S[15]);
                const bf16x8 p0 = __builtin_bit_cast(bf16x8, w0), p1 = __builtin_bit_cast(bf16x8, w1);
                O[x][0] = __builtin_amdgcn_mfma_f32_32x32x16_bf16(vf[0][0], p0, O[x][0], 0, 0, 0);
                O[x][0] = __builtin_amdgcn_mfma_f32_32x32x16_bf16(vf[0][1], p1, O[x][0], 0, 0, 0);
                O[x][1] = __builtin_amdgcn_mfma_f32_32x32x16_bf16(vf[1][0], p0, O[x][1], 0, 0, 0);
                O[x][1] = __builtin_amdgcn_mfma_f32_32x32x16_bf16(vf[1][1], p1, O[x][1], 0, 0, 0);
            }
        }
    }
    const int slast = ((kt1 - kt0) & 1) ^ s0;
    next.qload();
    typedef __attribute__((address_space(3))) unsigned char* lds_p;
    const int ch = lane & 7;
    if (MODE == 0) {
        const lds_p stg = (lds_p)wl + slast * 8192;
#pragma unroll
        for (int x = 0; x < NQ; ++x) {
            const float lt = xsum32(lsum[x]);
            const lds_p st = stg + x * 4096;
            const float inv = 1.f / lt;
#pragma unroll
            for (int blk = 0; blk < 2; ++blk)
#pragma unroll
                for (int rg = 0; rg < 4; ++rg) { u32x2 w; w.x = cvtpk(O[x][blk][4 * rg] * inv, O[x][blk][4 * rg + 1] * inv); w.y = cvtpk(O[x][blk][4 * rg + 2] * inv, O[x][blk][4 * rg + 3] * inv);
                    *(__attribute__((address_space(3))) u32x2*)(st + i * 128 + (((4 * blk + rg) ^ (i & 7)) * 16) + 8 * hi) = w; }
            out.lse[x] = mrun[x] + __builtin_amdgcn_logf(lt);
        }
        asm volatile("s_waitcnt lgkmcnt(0)" ::: "memory"); __builtin_amdgcn_wave_barrier();
#pragma unroll
        for (int x = 0; x < NQ; ++x)
#pragma unroll
            for (int p = 0; p < 4; ++p) out.v[x][p] = *(const __attribute__((address_space(3))) u32x4*)(stg + x * 4096 + (8 * p + kl8) * 128 + ((ch ^ kl8) * 16));
    } else {
        const lds_p stg = (lds_p)wl;
        asm volatile("s_waitcnt vmcnt(0)" ::: "memory"); __syncthreads();
        u32x4 pa16[4], pa4[4], pb16[4], pb4[4]; float la16, la4, lb16 = 0.f, lb4 = 0.f;
        const float* l16p = B.pl16 + (b * 8 + h) * SEQ; const float* l4p = B.pl4 + (b * 8 + h) * SEQ;
#pragma unroll
        for (int p = 0; p < 4; ++p) { const int tokr = b * SEQ + (u0 + 8 * p + kl8) * d + r;
            pa16[p] = *(const u32x4*)(B.po16 + (size_t)tokr * POPITCH + h * 64 + ch * 8); pa4[p] = *(const u32x4*)(B.po4 + (size_t)tokr * POPITCH + h * 64 + ch * 8); }
        { const int t = u0 + i; la16 = l16p[(t & 15) * (SEQ / 16) + (t >> 4)]; la4 = l4p[(t & 3) * (SEQ / 4) + (t >> 2)]; }
        if (NQ == 2) {
#pragma unroll
            for (int p = 0; p < 4; ++p) { const int tokr = b * SEQ + (u0 + 32 + 8 * p + kl8) * d + r;
                pb16[p] = *(const u32x4*)(B.po16 + (size_t)tokr * POPITCH + h * 64 + ch * 8); pb4[p] = *(const u32x4*)(B.po4 + (size_t)tokr * POPITCH + h * 64 + ch * 8); }
            const int t = u0 + 32 + i; lb16 = l16p[(t & 15) * (SEQ / 16) + (t >> 4)]; lb4 = l4p[(t & 3) * (SEQ / 4) + (t >> 2)]; }
#pragma unroll
        for (int x = 0; x < NQ; ++x) {
            const float lt = xsum32(lsum[x]);
            const lds_p st = stg + x * 4608;
            u32x4 p16[4], p4[4];
#pragma unroll
            for (int p = 0; p < 4; ++p) { p16[p] = x ? pb16[p] : pa16[p]; p4[p] = x ? pb4[p] : pa4[p]; }
            const float l16 = x ? lb16 : la16, l4 = x ? lb4 : la4;
            const float M = fmaxf(fmaxf(mrun[x], l16), l4);
            const float w1 = __builtin_amdgcn_exp2f(mrun[x] - M), w16 = __builtin_amdgcn_exp2f(l16 - M), w4 = __builtin_amdgcn_exp2f(l4 - M);
            const float den = 1.f / (w1 * lt + w16 + w4); const float inv = 1.f / lt;
#pragma unroll
            for (int blk = 0; blk < 2; ++blk)
#pragma unroll
                for (int rg = 0; rg < 4; ++rg) { u32x2 w; w.x = cvtpk(O[x][blk][4 * rg] * inv, O[x][blk][4 * rg + 1] * inv); w.y = cvtpk(O[x][blk][4 * rg + 2] * inv, O[x][blk][4 * rg + 3] * inv);
                    *(__attribute__((address_space(3))) u32x2*)(st + i * 144 + 64 * blk + 16 * rg + 8 * hi) = w; }
            if (hi == 0) *(__attribute__((address_space(3))) f32x4*)(stg + 9216 + x * 512 + i * 16) = (f32x4){w1 * lt * den, w16 * den, w4 * den, 0.f};
            asm volatile("s_waitcnt lgkmcnt(0)" ::: "memory"); __builtin_amdgcn_wave_barrier();
            float myss = 0.f;
#pragma unroll
            for (int p = 0; p < 4; ++p) { const int row = 8 * p + kl8; const int tokr = b * SEQ + (u0 + 32 * x + row) * d + r;
                const u32x4 ov = *(const __attribute__((address_space(3))) u32x4*)(st + row * 144 + ch * 16);
                const f32x4 av = *(const __attribute__((address_space(3))) f32x4*)(stg + 9216 + x * 512 + row * 16);
                const u32x4 a = p16[p], c4 = p4[p];
                const float o0 = av.x * bflo(ov.x) + av.y * bflo(a.x) + av.z * bflo(c4.x), o1 = av.x * bfhi(ov.x) + av.y * bfhi(a.x) + av.z * bfhi(c4.x);
                const float o2 = av.x * bflo(ov.y) + av.y * bflo(a.y) + av.z * bflo(c4.y), o3 = av.x * bfhi(ov.y) + av.y * bfhi(a.y) + av.z * bfhi(c4.y);
                const float o4 = av.x * bflo(ov.z) + av.y * bflo(a.z) + av.z * bflo(c4.z), o5 = av.x * bfhi(ov.z) + av.y * bfhi(a.z) + av.z * bfhi(c4.z);
                const float o6 = av.x * bflo(ov.w) + av.y * bflo(a.w) + av.z * bflo(c4.w), o7 = av.x * bfhi(ov.w) + av.y * bfhi(a.w) + av.z * bfhi(c4.w);
                float ss = (o0 * o0 + o1 * o1) + (o2 * o2 + o3 * o3) + (o4 * o4 + o5 * o5) + (o6 * o6 + o7 * o7);
                ss += __shfl_xor(ss, 1); ss += __shfl_xor(ss, 2); ss += __shfl_xor(ss, 4);
                u32x4 w; w.x = cvtpk(o0, o1); w.y = cvtpk(o2, o3); w.z = cvtpk(o4, o5); w.w = cvtpk(o6, o7);
                *(u32x4*)(B.mix + (size_t)tokr * DM + h * 64 + ch * 8) = w;
                myss = (ch == p) ? ss : myss; }
            if (ch < 4) B.sumsq[(b * 8 + h) * SEQ + u0 + 32 * x + 8 * ch + kl8] = myss;
        }
    }
    asm volatile("s_waitcnt lgkmcnt(0)" ::: "memory"); __builtin_amdgcn_wave_barrier();
    return slast ^ 1;
}

__device__ __forceinline__ void item(const Bufs& B, lds_cptr wl, unsigned wl_addr, int b, int s, int h, int wave, int lane) {
    const float slope2 = exp2f(-(float)(h + 1)) * LOG2E;
    QPre<1> Pa, Pb; QPre<2> Pc, Pd; Stash<1> Sa, Sb; Stash<2> Sc, Sd;
    prolog_dma(B, wl_addr, b, h, 16, 2 * wave, 32 * s, lane, 0); prolog_q<1>(B, b, h, 16, 2 * wave, 32 * s, lane, Pa);
    int s0 = 0;
    s0 = qgroup<1, 0>(B, wl, wl_addr, b, h, 16, 2 * wave, 32 * s, slope2, lane, Pa, s0, NoFlush{}, NextPro<1>{B, wl_addr, b, h, 16, 2 * wave + 1, 32 * s, lane, Pb}, Sa);
    s0 = qgroup<1, 0>(B, wl, wl_addr, b, h, 16, 2 * wave + 1, 32 * s, slope2, lane, Pb, s0, Flush<1>{B.po16, B.pl16, b, h, 16, 2 * wave, 32 * s, lane, Sa},
                      NextPro<2>{B, wl_addr, b, h, 4, wave >> 1, 128 * s + 64 * (wave & 1), lane, Pc}, Sb);
    s0 = qgroup<2, 0>(B, wl, wl_addr, b, h, 4, wave >> 1, 128 * s + 64 * (wave & 1), slope2, lane, Pc, s0, Flush<1>{B.po16, B.pl16, b, h, 16, 2 * wave + 1, 32 * s, lane, Sb},
                      NextPro<2>{B, wl_addr, b, h, 1, 0, 512 * s + 64 * wave, lane, Pd}, Sc);
    qgroup<2, 1>(B, wl, wl_addr, b, h, 1, 0, 512 * s + 64 * wave, slope2, lane, Pd, s0, Flush<2>{B.po4, B.pl4, b, h, 4, wave >> 1, 128 * s + 64 * (wave & 1), lane, Sc}, NoNext{}, Sd);
}
}

namespace hg {
using att::f32x16; using att::s16x4; using att::lds_cptr; using att::vtr; using att::cvtpk; using att::xsum32; using att::glds16;
typedef __attribute__((address_space(3))) unsigned short* lds_u16p;
__device__ __forceinline__ void item(const Ctx& F, int b, int h) {
    const bf16* proj = (const bf16*)(F.ws + WS_PROJ); bf16* mix = (bf16*)(F.ws + WS_MIX);
    const float* gamma = F.in[4]; const float* ghn = F.in[5];
    int lane = F.lane, tid = F.tid; const int wave = F.wave;
    asm volatile("" : "+v"(lane), "+v"(tid));
    LAS unsigned char* wl = F.lds + wave * 16384;
    const unsigned wl_addr = (unsigned)(uintptr_t)wl;
    LAS float* decay = (LAS float*)(F.lds + LDS_TAB);
    LAS float* gnl = (LAS float*)(F.lds + LDS_TAB + 2048);
    const int i = lane & 31, hi = lane >> 5, iq = i - 4 * hi;
    const float lb = 1.f / (1.f + __expf(gamma[512 + h * 64 + lane] - gamma[h * 64 + lane])), oml = 1.f - lb;
    if (wave == 0) gnl[lane] = ghn[h * 64 + lane];
    float Sf[8];
#pragma unroll
    for (int j = 0; j < 8; ++j) Sf[j] = 0.f;
    const int sv = tid >> 3, sko = tid & 7;
    const int ksw = (i >> 1) & 7;
    int raddr[4];
#pragma unroll
    for (int s = 0; s < 4; ++s) raddr[s] = i * 128 + (((2 * s + hi) ^ ksw) * 16);
    const int g16 = lane >> 4, i16 = lane & 15, kbit = (i16 >> 3) & 1, vrow = 4 * hi + (i16 >> 2), vcol = 2 * (g16 & 1) + ((i16 & 3) >> 1), vb8 = (i16 & 1) * 8;
    const int ta0 = vrow * 128 + (vcol + 4 * kbit) * 16 + vb8, ta1 = vrow * 128 + (vcol + 4 * (1 - kbit)) * 16 + vb8;
    const size_t rowB = (size_t)PPITCH * 2;
    const int kl8 = lane >> 3, sw = lane >> 4;
    const char* cb = (const char*)proj + ((size_t)b * SEQ + wave * 32 + kl8) * rowB + (size_t)h * 128;
    const int rs0 = ((lane & 7) ^ sw) * 16, rs1 = ((lane & 7) ^ (4 + sw)) * 16, vs0 = ((lane & 7) ^ ((sw & 1) << 2)) * 16;
    const size_t pstep = 8 * rowB, gstep = 256 * rowB;
#define HG_DMA_R(colbytes, grp_, region) do { const char* s_ = cb + (size_t)(grp_) * gstep + (colbytes); const unsigned lb_ = wl_addr + (region); \
        glds16(s_ + rs0, (unsigned)__builtin_amdgcn_readfirstlane(lb_)); glds16(s_ + pstep + rs1, (unsigned)__builtin_amdgcn_readfirstlane(lb_ + 1024u)); \
        glds16(s_ + 2 * pstep + rs0, (unsigned)__builtin_amdgcn_readfirstlane(lb_ + 2048u)); glds16(s_ + 3 * pstep + rs1, (unsigned)__builtin_amdgcn_readfirstlane(lb_ + 3072u)); } while (0)
#define HG_DMA_V(colbytes, grp_, region) do { const char* s_ = cb + (size_t)(grp_) * gstep + (colbytes) + vs0; const unsigned lb_ = wl_addr + (region); \
        glds16(s_, (unsigned)__builtin_amdgcn_readfirstlane(lb_)); glds16(s_ + pstep, (unsigned)__builtin_amdgcn_readfirstlane(lb_ + 1024u)); \
        glds16(s_ + 2 * pstep, (unsigned)__builtin_amdgcn_readfirstlane(lb_ + 2048u)); glds16(s_ + 3 * pstep, (unsigned)__builtin_amdgcn_readfirstlane(lb_ + 3072u)); } while (0)
    HG_DMA_R(C_HQ * 2, 0, 0u); HG_DMA_R(C_HF * 2, 0, 4096u); HG_DMA_V(C_HI * 2, 0, 12288u);
    for (int grp = 0; grp < 8; ++grp) {
        const int tok0 = b * SEQ + (grp * 8 + wave) * 32;
        if (grp == 0) asm volatile("s_waitcnt vmcnt(0)" ::: "memory"); else asm volatile("s_waitcnt vmcnt(8)" ::: "memory");
        {
            float E1 = 1.f;
            const int kc = lane >> 3, kw = (lane & 7) * 2;
#pragma unroll
            for (int tb = 0; tb < 4; ++tb) {
                float qv[8], fr[8];
#pragma unroll
                for (int j = 0; j < 8; ++j) { const int t = 8 * tb + j; const int rsw = (kc ^ ((t >> 1) & 7)) * 16 + kw;
                    qv[j] = bf2f(*(lds_u16p)(wl + t * 128 + rsw)); fr[j] = bf2f(*(lds_u16p)(wl + 4096 + t * 128 + rsw)); }
                float ff[8], ky[8], qs[8], ee[8];
#pragma unroll
                for (int j = 0; j < 8; ++j) { const float sg = __builtin_amdgcn_rcpf(1.f + __builtin_amdgcn_exp2f(-fr[j] * LOG2E));
                    ff[j] = lb + oml * sg; ky[j] = oml * (1.f - sg);
                    qs[j] = qv[j] * __builtin_amdgcn_rcpf(1.f + __builtin_amdgcn_exp2f(-qv[j] * LOG2E)); }
#pragma unroll
                for (int j = 0; j < 8; ++j) { E1 *= ff[j]; ee[j] = E1; }
#pragma unroll
                for (int j = 0; j < 8; ++j) { const int t = 8 * tb + j; const int rsw = (kc ^ ((t >> 1) & 7)) * 16 + kw;
                    const unsigned pk = cvtpk(qs[j] * ee[j], ky[j] * __builtin_amdgcn_rcpf(ee[j]));
                    *(lds_u16p)(wl + t * 128 + rsw) = (unsigned short)pk;
                    *(lds_u16p)(wl + 4096 + t * 128 + rsw) = (unsigned short)(pk >> 16); }
            }
            decay[wave * 64 + lane] = E1;
        }
        asm volatile("s_waitcnt lgkmcnt(0)" ::: "memory"); __builtin_amdgcn_wave_barrier();
        bf16x8 qfB[4];
        f32x16 oT[2];
        u32x4 gpre[4];
        {
            f32x16 AT;
#pragma unroll
            for (int e = 0; e < 16; ++e) AT[e] = 0.f;
#pragma unroll
            for (int s = 0; s < 4; ++s) { qfB[s] = *(const LAS bf16x8*)(wl + raddr[s]); const bf16x8 kfA = *(const LAS bf16x8*)(wl + 4096 + raddr[s]);
                AT = __builtin_amdgcn_mfma_f32_32x32x16_bf16(kfA, qfB[s], AT, 0, 0, 0); }
            asm volatile("s_waitcnt lgkmcnt(0)" ::: "memory");
            if (grp < 7) { HG_DMA_R(C_HQ * 2, grp + 1, 0u); asm volatile("s_waitcnt vmcnt(4)" ::: "memory"); } else asm volatile("s_waitcnt vmcnt(0)" ::: "memory");
#pragma unroll
            for (int e = 0; e < 16; ++e) AT[e] = (((e & 3) + 8 * (e >> 2)) <= iq) ? AT[e] : 0.f;
            u32x4 w0, w1;
            w0.x = cvtpk(AT[0], AT[1]); w0.y = cvtpk(AT[2], AT[3]); w0.z = cvtpk(AT[4], AT[5]); w0.w = cvtpk(AT[6], AT[7]);
            w1.x = cvtpk(AT[8], AT[9]); w1.y = cvtpk(AT[10], AT[11]); w1.z = cvtpk(AT[12], AT[13]); w1.w = cvtpk(AT[14], AT[15]);
            const bf16x8 p0 = __builtin_bit_cast(bf16x8, w0), p1 = __builtin_bit_cast(bf16x8, w1);
            bf16x8 vf[2][2], ef[2][2];
            const lds_cptr vs = (lds_cptr)(wl + 12288), es = (lds_cptr)(wl + 4096);
            const int swk = 2 * hi + kbit;
#pragma unroll
            for (int ks = 0; ks < 2; ++ks) {
                const s16x4 a0 = vtr(vs + ta0 + 2048 * ks), a1 = vtr(vs + ta0 + 2048 * ks + 1024), b0 = vtr(vs + ta1 + 2048 * ks), b1 = vtr(vs + ta1 + 2048 * ks + 1024);
                vf[0][ks] = (bf16x8){a0[0], a0[1], a0[2], a0[3], a1[0], a1[1], a1[2], a1[3]}; vf[1][ks] = (bf16x8){b0[0], b0[1], b0[2], b0[3], b1[0], b1[1], b1[2], b1[3]};
#pragma unroll
                for (int kb = 0; kb < 2; ++kb) {
                    const s16x4 c0 = vtr(es + 2048 * ks + vrow * 128 + (((4 * kb + vcol) ^ swk) * 16) + vb8);
                    const s16x4 c1 = vtr(es + 2048 * ks + 1024 + vrow * 128 + (((4 * kb + vcol) ^ (4 + swk)) * 16) + vb8);
                    ef[kb][ks] = (bf16x8){c0[0], c0[1], c0[2], c0[3], c1[0], c1[1], c1[2], c1[3]}; }
            }
#pragma unroll
            for (int vb = 0; vb < 2; ++vb) {
#pragma unroll
                for (int e = 0; e < 16; ++e) oT[vb][e] = 0.f;
                oT[vb] = __builtin_amdgcn_mfma_f32_32x32x16_bf16(vf[vb][0], p0, oT[vb], 0, 0, 0);
                oT[vb] = __builtin_amdgcn_mfma_f32_32x32x16_bf16(vf[vb][1], p1, oT[vb], 0, 0, 0); }
#pragma unroll
            for (int kb = 0; kb < 2; ++kb)
#pragma unroll
                for (int vb = 0; vb < 2; ++vb) {
                    f32x16 dS;
#pragma unroll
                    for (int e = 0; e < 16; ++e) dS[e] = 0.f;
                    dS = __builtin_amdgcn_mfma_f32_32x32x16_bf16(ef[kb][0], vf[vb][0], dS, 0, 0, 0);
                    dS = __builtin_amdgcn_mfma_f32_32x32x16_bf16(ef[kb][1], vf[vb][1], dS, 0, 0, 0);
                    const int v = 32 * vb + i;
#pragma unroll
                    for (int rg = 0; rg < 4; ++rg) { u32x2 w; w.x = cvtpk(dS[4 * rg], dS[4 * rg + 1]); w.y = cvtpk(dS[4 * rg + 2], dS[4 * rg + 3]);
                        *(LAS u32x2*)(wl + 8192 + vb * 4096 + i * 128 + (((4 * kb + rg) ^ (i & 7)) * 16) + 8 * hi) = w; }
                }
            if (grp < 7) HG_DMA_R(C_HF * 2, grp + 1, 4096u);
            { const bf16* grow = proj + (size_t)(tok0 + (lane >> 3)) * PPITCH + C_HG + h * 64 + 8 * (lane & 7);
#pragma unroll
              for (int p = 0; p < 4; ++p) gpre[p] = *(const u32x4*)(grow + (size_t)(8 * p) * PPITCH); }
        }
        __syncthreads();
#pragma unroll
        for (int c = 0; c < 8; ++c) {
            LAS u32x4* sp = (LAS u32x4*)(F.lds + c * 16384 + 8192 + (sv >> 5) * 4096 + (sv & 31) * 128 + ((sko ^ (sv & 7)) * 16));
            const u32x4 dv = *sp; const f32x4 d0 = *(const LAS f32x4*)(decay + c * 64 + 8 * sko), d1 = *(const LAS f32x4*)(decay + c * 64 + 8 * sko + 4);
            u32x4 o; o.x = cvtpk(Sf[0], Sf[1]); o.y = cvtpk(Sf[2], Sf[3]); o.z = cvtpk(Sf[4], Sf[5]); o.w = cvtpk(Sf[6], Sf[7]);
            *sp = o;
            Sf[0] = d0.x * (Sf[0] + bflo(dv.x)); Sf[1] = d0.y * (Sf[1] + bfhi(dv.x)); Sf[2] = d0.z * (Sf[2] + bflo(dv.y)); Sf[3] = d0.w * (Sf[3] + bfhi(dv.y));
            Sf[4] = d1.x * (Sf[4] + bflo(dv.z)); Sf[5] = d1.y * (Sf[5] + bfhi(dv.z)); Sf[6] = d1.z * (Sf[6] + bflo(dv.w)); Sf[7] = d1.w * (Sf[7] + bfhi(dv.w));
        }
        __syncthreads();
        {
            bf16x8 sf[2][4];
#pragma unroll
            for (int vb = 0; vb < 2; ++vb) { const int v = 32 * vb + i;
#pragma unroll
                for (int s = 0; s < 4; ++s) sf[vb][s] = *(const LAS bf16x8*)(wl + 8192 + vb * 4096 + i * 128 + (((2 * s + hi) ^ (i & 7)) * 16)); }
            asm volatile("s_waitcnt lgkmcnt(0)" ::: "memory");
#pragma unroll
            for (int vb = 0; vb < 2; ++vb)
#pragma unroll
                for (int s = 0; s < 4; ++s) oT[vb] = __builtin_amdgcn_mfma_f32_32x32x16_bf16(sf[vb][s], qfB[s], oT[vb], 0, 0, 0);
        }
        {
            float ss = 0.f;
#pragma unroll
            for (int vb = 0; vb < 2; ++vb)
#pragma unroll
                for (int e = 0; e < 16; ++e) ss += oT[vb][e] * oT[vb][e];
            ss = xsum32(ss);
            const float rstd = 1.f / sqrtf(ss * (1.f / 64.f) + EPS);
            LAS unsigned char* st = wl + 8192;
#pragma unroll
            for (int vb = 0; vb < 2; ++vb)
#pragma unroll
                for (int rg = 0; rg < 4; ++rg) { u32x2 w; w.x = cvtpk(oT[vb][4 * rg] * rstd, oT[vb][4 * rg + 1] * rstd); w.y = cvtpk(oT[vb][4 * rg + 2] * rstd, oT[vb][4 * rg + 3] * rstd);
                    *(LAS u32x2*)(st + i * 128 + (((4 * vb + rg) ^ (i & 7)) * 16) + 8 * hi) = w; }
            asm volatile("s_waitcnt lgkmcnt(0)" ::: "memory"); __builtin_amdgcn_wave_barrier();
            const int ch = lane & 7, r8 = lane >> 3;
            const f32x4 gw0 = *(const LAS f32x4*)(gnl + 8 * ch), gw1 = *(const LAS f32x4*)(gnl + 8 * ch + 4);
#pragma unroll
            for (int p = 0; p < 4; ++p) { const int row = 8 * p + r8; const u32x4 ov = *(const LAS u32x4*)(st + row * 128 + ((ch ^ (row & 7)) * 16)); const u32x4 gp = gpre[p];
                u32x4 w;
                w.x = cvtpk(bflo(ov.x) * gw0.x * pg8::silu_f(bflo(gp.x)), bfhi(ov.x) * gw0.y * pg8::silu_f(bfhi(gp.x)));
                w.y = cvtpk(bflo(ov.y) * gw0.z * pg8::silu_f(bflo(gp.y)), bfhi(ov.y) * gw0.w * pg8::silu_f(bfhi(gp.y)));
                w.z = cvtpk(bflo(ov.z) * gw1.x * pg8::silu_f(bflo(gp.z)), bfhi(ov.z) * gw1.y * pg8::silu_f(bfhi(gp.z)));
                w.w = cvtpk(bflo(ov.w) * gw1.z * pg8::silu_f(bflo(gp.w)), bfhi(ov.w) * gw1.w * pg8::silu_f(bfhi(gp.w)));
                *(u32x4*)(mix + (size_t)(tok0 + row) * DM + 512 + h * 64 + 8 * ch) = w; }
            asm volatile("s_waitcnt lgkmcnt(0)" ::: "memory"); __builtin_amdgcn_wave_barrier();
            if (grp < 7) HG_DMA_V(C_HI * 2, grp + 1, 12288u);
        }
    }
#undef HG_DMA_R
#undef HG_DMA_V
}
}

constexpr int CW_Q = 12288;
__device__ __forceinline__ void mixer_phase(const Ctx& F, int qoff) {
    att::Bufs B; B.proj = (const bf16*)(F.ws + WS_PROJ);
    unsigned char* scr = (unsigned char*)F.out;
    B.po16 = (bf16*)scr; B.po4 = (bf16*)(scr + 40 * MiB); B.pl16 = (float*)(scr + 80 * MiB); B.pl4 = (float*)(scr + 81 * MiB);
    B.mix = (bf16*)(F.ws + WS_MIX); B.sumsq = (float*)(F.ws + WS_SUMSQ);
    const att::lds_cptr wl = (att::lds_cptr)(F.lds + F.wave * 16384);
    const unsigned wl_addr = (unsigned)(uintptr_t)(F.lds + F.wave * 16384);
    unsigned* q = (unsigned*)(F.ws + WS_CTL) + CW_Q + qoff;
    volatile LAS unsigned* MISC = (volatile LAS unsigned*)(F.lds + LDS_MISC);
    for (;;) {
        __syncthreads();
        if (F.tid == 0) MISC[16] = __hip_atomic_fetch_add(q, 1u, __ATOMIC_RELAXED, __HIP_MEMORY_SCOPE_AGENT);
        __syncthreads();
        const int id = (int)__builtin_amdgcn_readfirstlane(MISC[16]);
        if (id >= 896) break;
        if (id < 128) { hg::item(F, id >> 3, id & 7); continue; }
        int a = -1, c = -1;
        if (id < 128 + 640) { const int g = (id - 128) / 5, rr = (id - 128) % 5; if (rr < 4) a = 4 * g + rr; else c = g; }
        else c = 128 + (id - 768);
        if (a >= 0) att::item(B, wl, wl_addr, (a & 127) >> 3, 3 - (a >> 7), a & 7, F.wave, F.lane);
        else {
            LAS float* scr = (LAS float*)(F.lds + F.wave * 16384);
            for (int j = 0; j < 4; ++j) { const int t0 = 64 * c + 8 * F.wave + 2 * j;
                moe_convert_pair(F, (t0 >> 9) * 768 + (t0 & 511), ((t0 + 1) >> 9) * 768 + ((t0 + 1) & 511), scr, F.lane); } }
    }
}

constexpr int RT_ROWB = 2064;
__device__ __forceinline__ void route_mfma(const Ctx& F, const bool probe = false) {
    const bf16* x2 = (const bf16*)(F.ws + WS_H); unsigned char* H = (unsigned char*)(F.ws + WS_MIX); const float* g2 = F.in[7]; const bf16* wrt = (const bf16*)(F.ws + WS_WRT);
    const float* bgrp = F.in[9]; const float* bexp = F.in[11];
    int* tokl = (int*)(F.ws + (probe ? WS_PROJ : WS_TOKL)); float* gatel = (float*)(F.ws + (probe ? WS_PROJ + 8 * MiB : WS_GATEL)); int* slot = (int*)(F.ws + (probe ? WS_PROJ + 16 * MiB : WS_SLOT));
    unsigned* ctl = (unsigned*)(F.ws + WS_CTL) + (probe ? 4096 : 0); const float* ss2 = (const float*)(F.ws + WS_SSP);
    LAS unsigned char* wl = F.lds;
    LAS int* hist = (LAS int*)(F.lds + LDS_TAB);
    LAS int* gbase = hist + 32;
    LAS int* sel_e = gbase + 32;
    LAS int* sel_r = sel_e + 256;
    LAS float* sel_g = (LAS float*)(sel_r + 256);
    const int lane = F.lane, col = lane & 15, kq = lane >> 4;
    LAS unsigned char* g2l = F.lds + 2 * 36 * RT_ROWB;
    if (F.tid < 128) { const f32x4 ga = *(const f32x4*)(g2 + 8 * F.tid), gb = *(const f32x4*)(g2 + 8 * F.tid + 4);
        u32x4 gp; gp.x = att::cvtpk(ga.x, ga.y); gp.y = att::cvtpk(ga.z, ga.w); gp.z = att::cvtpk(gb.x, gb.y); gp.w = att::cvtpk(gb.z, gb.w); *(LAS u32x4*)(g2l + 16 * F.tid) = gp; }
    u32x4 xpre[16]; float ssq = 0.f;
    if (F.vcu < NTOK / 128) { const int tok = F.vcu * 128 + F.wave * 16 + col; { float pv[16];
#pragma unroll
            for (int j = 0; j < 16; ++j) pv[j] = ss2[(size_t)j * NTOK + tok];
            ssq = (((pv[0] + pv[1]) + (pv[2] + pv[3])) + ((pv[4] + pv[5]) + (pv[6] + pv[7]))) + (((pv[8] + pv[9]) + (pv[10] + pv[11])) + ((pv[12] + pv[13]) + (pv[14] + pv[15]))); }
        const bf16* xr = x2 + (size_t)tok * DM + 8 * kq;
#pragma unroll
        for (int S = 0; S < 16; ++S) xpre[S] = *(const u32x4*)(xr + 32 * S); }
    { const u32x4* s = (const u32x4*)wrt; u32x4 tv[18];
#pragma unroll
      for (int j = 0; j < 18; ++j) tv[j] = s[F.tid + j * NTHR];
#pragma unroll
      for (int j = 0; j < 18; ++j) { const int i = F.tid + j * NTHR, row = i >> 7, c = i & 127; *(LAS u32x4*)(wl + row * RT_ROWB + c * 16) = tv[j]; } }
    for (int chunk = F.vcu; chunk < NTOK / 128; chunk += F.G) {
        if (F.tid < 32) hist[F.tid] = 0;
        __syncthreads();
        {
            const int tok0 = chunk * 128 + F.wave * 16, tok = tok0 + col;
            const float rstd = 1.f / sqrtf(ssq * (1.f / DM) + EPS);
            const bf16* xr = x2 + (size_t)tok * DM + 8 * kq; const LAS unsigned char* gr = g2l + 16 * kq; unsigned char* hr = H + (size_t)tok * DM + 8 * kq;
            const LAS unsigned char* w0 = wl + col * RT_ROWB + 16 * kq; const LAS unsigned char* w1 = wl + (16 + col) * RT_ROWB + 16 * kq; const LAS unsigned char* w2 = wl + (32 + (col & 3)) * RT_ROWB + 16 * kq;
            constexpr int LO = 36 * RT_ROWB;
            f32x4 a0 = {0.f, 0.f, 0.f, 0.f}, a1 = a0, a2 = a0;
            u32x4 xlate[16];
#pragma unroll
            for (int S = 0; S < 16; ++S) xlate[S] = *(const u32x4*)(xr + 32 * (16 + S));
#pragma unroll
            for (int S = 0; S < 16; ++S) {
                const u32x4 xv = xpre[S];
                const u32x4 gv = *(const LAS u32x4*)(gr + 64 * S);
                u32x2 hw; hw.x = pg8::pk4_fp8(bflo(xv.x) * bflo(gv.x) * rstd, bfhi(xv.x) * bfhi(gv.x) * rstd, bflo(xv.y) * bflo(gv.y) * rstd, bfhi(xv.y) * bfhi(gv.y) * rstd);
                hw.y = pg8::pk4_fp8(bflo(xv.z) * bflo(gv.z) * rstd, bfhi(xv.z) * bfhi(gv.z) * rstd, bflo(xv.w) * bflo(gv.w) * rstd, bfhi(xv.w) * bfhi(gv.w) * rstd);
                *(u32x2*)(hr + 32 * S) = hw;
                const bf16x8 av = __builtin_bit_cast(bf16x8, xv);
                const bf16x8 h0 = *(const LAS bf16x8*)(w0 + 64 * S), h1 = *(const LAS bf16x8*)(w1 + 64 * S), h2 = *(const LAS bf16x8*)(w2 + 64 * S);
                const bf16x8 l0 = *(const LAS bf16x8*)(w0 + LO + 64 * S), l1 = *(const LAS bf16x8*)(w1 + LO + 64 * S), l2 = *(const LAS bf16x8*)(w2 + LO + 64 * S);
                a0 = __builtin_amdgcn_mfma_f32_16x16x32_bf16(av, h0, a0, 0, 0, 0); a0 = __builtin_amdgcn_mfma_f32_16x16x32_bf16(av, l0, a0, 0, 0, 0);
                a1 = __builtin_amdgcn_mfma_f32_16x16x32_bf16(av, h1, a1, 0, 0, 0); a1 = __builtin_amdgcn_mfma_f32_16x16x32_bf16(av, l1, a1, 0, 0, 0);
                a2 = __builtin_amdgcn_mfma_f32_16x16x32_bf16(av, h2, a2, 0, 0, 0); a2 = __builtin_amdgcn_mfma_f32_16x16x32_bf16(av, l2, a2, 0, 0, 0);
            }
#pragma unroll
            for (int S = 16; S < 32; ++S) {
                const u32x4 xv = xlate[S - 16];
                const u32x4 gv = *(const LAS u32x4*)(gr + 64 * S);
                u32x2 hw; hw.x = pg8::pk4_fp8(bflo(xv.x) * bflo(gv.x) * rstd, bfhi(xv.x) * bfhi(gv.x) * rstd, bflo(xv.y) * bflo(gv.y) * rstd, bfhi(xv.y) * bfhi(gv.y) * rstd);
                hw.y = pg8::pk4_fp8(bflo(xv.z) * bflo(gv.z) * rstd, bfhi(xv.z) * bfhi(gv.z) * rstd, bflo(xv.w) * bflo(gv.w) * rstd, bfhi(xv.w) * bfhi(gv.w) * rstd);
                *(u32x2*)(hr + 32 * S) = hw;
                const bf16x8 av = __builtin_bit_cast(bf16x8, xv);
                const bf16x8 h0 = *(const LAS bf16x8*)(w0 + 64 * S), h1 = *(const LAS bf16x8*)(w1 + 64 * S), h2 = *(const LAS bf16x8*)(w2 + 64 * S);
                const bf16x8 l0 = *(const LAS bf16x8*)(w0 + LO + 64 * S), l1 = *(const LAS bf16x8*)(w1 + LO + 64 * S), l2 = *(const LAS bf16x8*)(w2 + LO + 64 * S);
                a0 = __builtin_amdgcn_mfma_f32_16x16x32_bf16(av, h0, a0, 0, 0, 0); a0 = __builtin_amdgcn_mfma_f32_16x16x32_bf16(av, l0, a0, 0, 0, 0);
                a1 = __builtin_amdgcn_mfma_f32_16x16x32_bf16(av, h1, a1, 0, 0, 0); a1 = __builtin_amdgcn_mfma_f32_16x16x32_bf16(av, l1, a1, 0, 0, 0);
                a2 = __builtin_amdgcn_mfma_f32_16x16x32_bf16(av, h2, a2, 0, 0, 0); a2 = __builtin_amdgcn_mfma_f32_16x16x32_bf16(av, l2, a2, 0, 0, 0);
            }
            { float rs[4];
#pragma unroll
              for (int e = 0; e < 4; ++e) rs[e] = __shfl(rstd, 4 * kq + e);
#pragma unroll
              for (int e = 0; e < 4; ++e) { a0[e] *= rs[e]; a1[e] *= rs[e]; a2[e] *= rs[e]; } }
            const int rowbase = lane & 48;
            const float bia0 = (col < 4) ? bgrp[col] : bexp[col - 4], bia1 = bexp[12 + col], bia2 = (col < 4) ? bexp[28 + col] : 0.f;
#pragma unroll
            for (int e = 0; e < 4; ++e) {
                const float x0 = a0[e] + bia0, x1 = a1[e] + bia1, x2v = a2[e] + bia2;
                const float l0 = __shfl(x0, rowbase), l1 = __shfl(x0, rowbase + 1), l2 = __shfl(x0, rowbase + 2), l3 = __shfl(x0, rowbase + 3);
                int gs = 0; float gm = l0; if (l1 > gm) { gm = l1; gs = 1; } if (l2 > gm) { gm = l2; gs = 2; } if (l3 > gm) { gm = l3; gs = 3; }
                const float wg = 1.f / (expf(l0 - gm) + expf(l1 - gm) + expf(l2 - gm) + expf(l3 - gm));
                int i0 = 0, i1 = -1; float v0 = -INFINITY, v1 = -INFINITY;
#pragma unroll
                for (int i = 0; i < 8; ++i) { const int c = 4 + 8 * gs + i, src = rowbase + (c & 15);
                    const float s0 = __shfl(x0, src), s1 = __shfl(x1, src), s2 = __shfl(x2v, src);
                    const float v = (c < 16) ? s0 : ((c < 32) ? s1 : s2);
                    if (v > v0) { v1 = v0; i1 = i0; v0 = v; i0 = i; } else if (v > v1) { v1 = v; i1 = i; } }
                const float p0 = 1.f / (1.f + expf(v1 - v0)), p1 = 1.f - p0;
                if (col == 0) { const int li = F.wave * 16 + 4 * kq + e, e0 = gs * 8 + i0, e1 = gs * 8 + i1;
                    sel_e[li * 2] = e0; sel_e[li * 2 + 1] = e1; sel_g[li * 2] = wg * p0; sel_g[li * 2 + 1] = wg * p1;
                    sel_r[li * 2] = atomicAdd((int*)&hist[e0], 1); sel_r[li * 2 + 1] = atomicAdd((int*)&hist[e1], 1); }
            }
        }
        __syncthreads();
        if (F.tid < 32) gbase[F.tid] = (int)atomicAdd(ctl + CW_CNT + 64 * F.tid, (unsigned)hist[F.tid]);
        __syncthreads();
        if (F.tid < 256) { const int li = F.tid >> 1, tok = chunk * 128 + li; const int e = sel_e[F.tid], pos = gbase[e] + sel_r[F.tid];
            tokl[e * LISTCAP + pos] = tok; gatel[e * LISTCAP + pos] = sel_g[F.tid]; slot[tok * 2 + (F.tid & 1)] = e * LISTCAP + pos; }
        if (chunk + F.G < NTOK / 128) { const int tok = (chunk + F.G) * 128 + F.wave * 16 + col; { float pv[16];
#pragma unroll
            for (int j = 0; j < 16; ++j) pv[j] = ss2[(size_t)j * NTOK + tok];
            ssq = (((pv[0] + pv[1]) + (pv[2] + pv[3])) + ((pv[4] + pv[5]) + (pv[6] + pv[7]))) + (((pv[8] + pv[9]) + (pv[10] + pv[11])) + ((pv[12] + pv[13]) + (pv[14] + pv[15]))); }
            const bf16* xr = x2 + (size_t)tok * DM + 8 * kq;
#pragma unroll
            for (int S = 0; S < 16; ++S) xpre[S] = *(const u32x4*)(xr + 32 * S); }
        __syncthreads();
    }
}

__device__ __forceinline__ int moe_tables(const Ctx& F) {
    LAS int* tab = (LAS int*)(F.lds + LDS_TAB); unsigned* ctl = (unsigned*)(F.ws + WS_CTL);
    __syncthreads();
    if (F.tid < 32) {
        const int e = F.tid, c = (int)__hip_atomic_load(ctl + CW_CNT + 64 * e, __ATOMIC_RELAXED, __HIP_MEMORY_SCOPE_AGENT);
        const int nt = (c + 255) >> 8; int ps = nt;
#pragma unroll
        for (int d = 1; d < 32; d <<= 1) { const int v = __shfl_up(ps, d); if (e >= d) ps += v; }
        const int start = ps - nt;
        tab[3 * MAXMT + e] = start * 256;
        if (e == 31) tab[3 * MAXMT + 32] = ps;
        for (int r = 0; r < nt; ++r) { const int mt = start + r; tab[3 * mt] = e; tab[3 * mt + 1] = e * LISTCAP + 256 * r; tab[3 * mt + 2] = (c - 256 * r) < 256 ? (c - 256 * r) : 256; }
    }
    __syncthreads();
    return tab[3 * MAXMT + 32];
}

__device__ __forceinline__ void final_phase(const Ctx& F, float* dst) {
    float* out = F.out; const unsigned char* Y = (const unsigned char*)(F.ws + WS_Y); const int* slot = (const int*)(F.ws + WS_SLOT); const float* gf = F.in[15];
    const LAS int* tab = (const LAS int*)(F.lds + LDS_TAB);
    const int gw = F.vcu * NWAVES + F.wave, NGW = F.G * NWAVES, lane = F.lane;
    f32x4 gv[4];
#pragma unroll
    for (int j = 0; j < 4; ++j) gv[j] = ((const f32x4*)gf)[lane + 64 * j];
    for (int tok = gw; tok < NTOK; tok += NGW) {
        const int s0 = slot[tok * 2], s1 = slot[tok * 2 + 1];
        const int r0 = tab[3 * MAXMT + (s0 >> 15)] + (s0 & (LISTCAP - 1)), r1 = tab[3 * MAXMT + (s1 >> 15)] + (s1 & (LISTCAP - 1));
        f32x4* xr = (f32x4*)(out + (size_t)tok * DM) + lane; const u32x2* x2r = (const u32x2*)((const bf16*)(F.ws + WS_H) + (size_t)tok * DM) + lane;
        const unsigned* y0 = (const unsigned*)(Y + (size_t)r0 * DM) + lane; const unsigned* y1 = (const unsigned*)(Y + (size_t)r1 * DM) + lane;
        f32x4 v[4]; float s = 0.f;
#pragma unroll
        for (int j = 0; j < 4; ++j) { const u32x2 xx = x2r[64 * j]; v[j] = (f32x4){bflo(xx.x), bfhi(xx.x), bflo(xx.y), bfhi(xx.y)}; const unsigned a = y0[64 * j], b = y1[64 * j];
            { const f32x2 a01 = __builtin_amdgcn_cvt_pk_f32_fp8((int)a, false), a23 = __builtin_amdgcn_cvt_pk_f32_fp8((int)a, true), b01 = __builtin_amdgcn_cvt_pk_f32_fp8((int)b, false), b23 = __builtin_amdgcn_cvt_pk_f32_fp8((int)b, true);
              v[j].x += (a01.x + b01.x) * 0.0625f; v[j].y += (a01.y + b01.y) * 0.0625f; v[j].z += (a23.x + b23.x) * 0.0625f; v[j].w += (a23.y + b23.y) * 0.0625f; }
            s += (v[j].x * v[j].x + v[j].y * v[j].y) + (v[j].z * v[j].z + v[j].w * v[j].w); }
        const float rstd = 1.f / sqrtf(wave_sum(s) * (1.f / DM) + EPS);
#pragma unroll
        for (int j = 0; j < 4; ++j) ((f32x4*)(dst + (size_t)tok * DM) + lane)[64 * j] = v[j] * rstd * gv[j];
    }
}

constexpr int NPHASE = 9;
struct Args { const float* in[16]; float* out; unsigned char* ws; int ph_lo, ph_hi; };
__global__ void __launch_bounds__(NTHR, 2) fwd(Args args) {
    extern __shared__ __attribute__((aligned(16))) unsigned char lds_raw[];
    Ctx F;
    F.lds = (LAS unsigned char*)lds_raw;
    F.tid = threadIdx.x; F.lane = F.tid & 63; F.wave = __builtin_amdgcn_readfirstlane(F.tid >> 6);
    F.G = gridDim.x; { const int bx = blockIdx.x; F.vcu = (F.G % 8 == 0) ? (bx % 8) * (F.G / 8) + bx / 8 : bx; }
#pragma unroll
    for (int i = 0; i < 16; ++i) F.in[i] = args.in[i];
    F.out = args.out; F.ws = args.ws;
    volatile LAS unsigned* MISC = (volatile LAS unsigned*)(F.lds + LDS_MISC);
    if (F.tid < 32) MISC[F.tid] = 0u;
    __syncthreads();
    unsigned* ctl = (unsigned*)(F.ws + WS_CTL);
#if MK_FUSED
    XcdBarrier bar = xcd_barrier_post(ctl + CW_BAR, MISC + 8);
#define GRID_BAR() xcd_barrier(bar)
#else
#define GRID_BAR() do {} while (0)
#endif
    const int lo = args.ph_lo, hi = args.ph_hi;
#define IN(k) (lo <= (k) && (k) < hi)
#define BOTH(k) (IN(k) && IN((k) + 1))
    LAS unsigned char* ring = F.lds;

    if (IN(0)) { p0_prologue(F); if (PROBE_DUP == 0) { GRID_BAR(); p0_prologue(F); } if (BOTH(0)) GRID_BAR(); }
    if (IN(1)) {
        pg8::PlainSched S; S.init(NTOK, NPROJ, DM, F.G, (int)blockIdx.x, F.ws + WS_WIN);
        pg8::EpiProj E{(bf16_t*)(F.ws + WS_PROJ), PPITCH, QSCALE, (const float*)(F.ws + WS_SUMSQ)};
        pg8::gemm_phase<pg8::EpiProj, pg8::PlainSched, true>(ring, F.ws + WS_H, DM, S, E);
        if (PROBE_DUP == 1) { GRID_BAR(); pg8::gemm_phase<pg8::EpiProj, pg8::PlainSched, true>(ring, F.ws + WS_H, DM, S, E); }
        if (BOTH(1)) GRID_BAR();
    }
    if (IN(2)) { mixer_phase(F, 0); if (PROBE_DUP == 2) { GRID_BAR(); mixer_phase(F, 1024); } if (BOTH(2)) GRID_BAR(); }
    if (IN(4)) {
        pg8::PlainSched S; S.init(NTOK, DM, DM, F.G, (int)blockIdx.x, F.ws + WS_WOUT);
        LAS float* rtab = (LAS float*)(F.lds + LDS_TAB);
        { const float* sumsq = (const float*)(F.ws + WS_SUMSQ);
          for (int ui = 0; ui < 2; ++ui) { pg8::Unit u; if (!S.next(ui, u)) break;
              if (F.tid < 256) { const int tok = u.pm * 256 + F.tid; const float* sp = sumsq + (size_t)(tok >> 11) * 8 * SEQ + (tok & (SEQ - 1));
                  const float a0 = sp[0] + sp[SEQ], a1 = sp[2 * SEQ] + sp[3 * SEQ], a2 = sp[4 * SEQ] + sp[5 * SEQ], a3 = sp[6 * SEQ] + sp[7 * SEQ];
                  rtab[256 * ui + F.tid] = 1.f / sqrtf(((a0 + a1) + (a2 + a3)) * (1.f / 512.f) + EPS); } }
          __syncthreads(); }
        pg8::EpiRes E{(const bf16_t*)(F.ws + WS_H), (bf16_t*)(F.ws + WS_H), DM, (float*)(F.ws + WS_SSP), rtab};
                pg8::gemm_phase<pg8::EpiRes, pg8::PlainSched, true>(ring, F.ws + WS_MIX, DM, S, E);
        if (BOTH(4)) GRID_BAR();
    }
    if (IN(5)) { if (PROBE_DUP == 5) { route_mfma(F, true); GRID_BAR(); } route_mfma(F); if (BOTH(5)) GRID_BAR(); }
    if (IN(6)) {
        const int T = moe_tables(F);
        pg8::MoeSched<true> S; S.G = F.G; S.c = (int)blockIdx.x; S.T = T; S.K = DM / 2; S.tab = (const LAS int*)(F.lds + LDS_TAB); S.tokl = (const int*)(F.ws + WS_TOKL); S.W = (const char*)(F.ws + WS_WGU); S.wexp = (size_t)DM * DM;
        pg8::EpiGU E{(unsigned char*)(F.ws + WS_HID)};
        pg8::gemm_phase<pg8::EpiGU, pg8::MoeSched<true>, true, true>(ring, F.ws + WS_MIX, DM / 2, S, E);
        if (PROBE_DUP == 6) { GRID_BAR(); pg8::gemm_phase<pg8::EpiGU, pg8::MoeSched<true>, true, true>(ring, F.ws + WS_MIX, DM / 2, S, E); }
        {
            unsigned* q2 = (unsigned*)(F.ws + WS_CTL) + CW_Q + 128;
            for (;;) {
                __syncthreads();
                if (F.tid == 0) MISC[16] = __hip_atomic_fetch_add(q2, 1u, __ATOMIC_RELAXED, __HIP_MEMORY_SCOPE_AGENT);
                __syncthreads();
                const int id = (int)__builtin_amdgcn_readfirstlane(MISC[16]);
                if (id >= 256) break;
                LAS float* scr = (LAS float*)(F.lds + F.wave * 16384);
                for (int j = 0; j < 2; ++j) { const int t0 = 32 * id + 4 * F.wave + 2 * j;
                    moe_convert_pair(F, (t0 >> 8) * 768 + 512 + (t0 & 255), ((t0 + 1) >> 8) * 768 + 512 + ((t0 + 1) & 255), scr, F.lane); }
            }
        }
        if (BOTH(6)) GRID_BAR();
    }
    if (IN(7)) {
        const int T = moe_tables(F);
        pg8::MoeSched<false> S; S.G = F.G; S.c = (int)blockIdx.x; S.T = T; S.K = DEXP / 2; S.tab = (const LAS int*)(F.lds + LDS_TAB); S.tokl = nullptr; S.W = (const char*)(F.ws + WS_WD); S.wexp = (size_t)DM * DEXP;
        pg8::EpiDown E{(unsigned char*)(F.ws + WS_Y), (const float*)(F.ws + WS_GATEL)};
        pg8::gemm_phase<pg8::EpiDown, pg8::MoeSched<false>, true, true>(ring, F.ws + WS_HID, DEXP / 2, S, E);
        if (PROBE_DUP == 7) { GRID_BAR(); pg8::gemm_phase<pg8::EpiDown, pg8::MoeSched<false>, true, true>(ring, F.ws + WS_HID, DEXP / 2, S, E); }
        if (BOTH(7)) GRID_BAR();
    }
    if (IN(8)) { (void)moe_tables(F); if (PROBE_DUP == 8) { final_phase(F, (float*)(F.ws + WS_MIX)); GRID_BAR(); } final_phase(F, F.out); }
#undef IN
#undef BOTH
}

extern "C" void kernel_launch(void* const* d_in, const int* in_sizes, int n_in, void* d_out, int out_size, void* d_ws, size_t ws_size, hipStream_t stream) {
    static int grid = 0;
    if (grid == 0) {
        if (n_in != 16 || out_size != NTOK * DM || ws_size < WS_END) { fprintf(stderr, "kernel_launch: unexpected shapes (n_in %d out %d ws %zu)\n", n_in, out_size, ws_size); grid = -1; return; }
        int dev = 0, cus = 0, per_cu = 0;
        if (hipGetDevice(&dev) != hipSuccess || hipDeviceGetAttribute(&cus, hipDeviceAttributeMultiprocessorCount, dev) != hipSuccess) { grid = -1; return; }
        if (hipFuncSetAttribute((const void*)fwd, hipFuncAttributeMaxDynamicSharedMemorySize, LDS_BYTES) != hipSuccess) { fprintf(stderr, "kernel_launch: hipFuncSetAttribute failed\n"); grid = -1; return; }
        if (hipOccupancyMaxActiveBlocksPerMultiprocessor(&per_cu, (const void*)fwd, NTHR, LDS_BYTES) != hipSuccess || per_cu < 1) fprintf(stderr, "kernel_launch: occupancy query reports %d\n", per_cu);
        (void)hipGetLastError();
        grid = cus;
    }
    if (grid < 0) return;
    (void)hipMemsetAsync((char*)d_ws + WS_CTL, 0, CTL_ZERO_BYTES, stream);
    Args a{};
    for (int i = 0; i < 16; ++i) a.in[i] = (const float*)d_in[i];
    a.out = (float*)d_out; a.ws = (unsigned char*)d_ws;
#if MK_FUSED
    a.ph_lo = 0; a.ph_hi = NPHASE;
    hipLaunchKernelGGL(fwd, dim3(grid), dim3(NTHR), LDS_BYTES, stream, a);
#else
    for (int p = 0; p < NPHASE; ++p) { a.ph_lo = p; a.ph_hi = p + 1; hipLaunchKernelGGL(fwd, dim3(grid), dim3(NTHR), LDS_BYTES, stream, a); }
#endif
}
```

```cpp
#include <hip/hip_runtime.h>
#include <cstdio>
#include <cstdint>

#ifndef PROBE_DUP
#define PROBE_DUP -1
#endif
#ifndef MK_FUSED
#define MK_FUSED 1
#endif

#define GAS __attribute__((address_space(1)))
#define LAS __attribute__((address_space(3)))
typedef unsigned short bf16;
typedef unsigned short bf16_t;
typedef short bf16x8 __attribute__((ext_vector_type(8)));
typedef float f32x4 __attribute__((ext_vector_type(4)));
typedef float f32x2 __attribute__((ext_vector_type(2)));
typedef unsigned u32x4 __attribute__((ext_vector_type(4)));
typedef unsigned u32x2 __attribute__((ext_vector_type(2)));
typedef GAS unsigned gu32;

constexpr int NWAVES = 8, NTHR = 512;
constexpr int NTOK = 32768, DM = 1024, SEQ = 2048, NBATCH = 16, NH = 8, HD = 64;
constexpr int NPROJ = 3584;
constexpr int PPITCH = 3712;
constexpr int POPITCH = 640;
constexpr int C_Q = 0, C_K = 512, C_V = 1024, C_HQ = 1536, C_HF = 2048, C_HI = 2560, C_HG = 3072;
constexpr int NEXP = 32, DEXP = 512, LISTCAP = 32768;
constexpr int MAXMT = 288, PROWS = MAXMT * 256;
constexpr float EPS = 1e-6f;
constexpr float LOG2E = 1.4426950408889634f;
constexpr float QSCALE = 0.125f * LOG2E;

constexpr size_t MiB = 1u << 20;
constexpr size_t WS_CTL = 0, CTL_ZERO_BYTES = 1 * MiB;
constexpr size_t WS_TOKL = 1 * MiB;
constexpr size_t WS_GATEL = 5 * MiB;
constexpr size_t WS_SLOT = 9 * MiB;
constexpr size_t WS_SUMSQ = 10 * MiB;
constexpr size_t WS_WRT = 11 * MiB;
constexpr size_t WS_WIN = 16 * MiB;
constexpr size_t WS_WOUT = 24 * MiB;
constexpr size_t WS_WGU = 32 * MiB;
constexpr size_t WS_WD = 96 * MiB;
constexpr size_t WS_H = 128 * MiB;
constexpr size_t WS_MIX = 192 * MiB;
constexpr size_t WS_PROJ = 256 * MiB;
constexpr size_t WS_HID = 256 * MiB;
constexpr size_t WS_Y = 328 * MiB;
constexpr size_t WS_END = 488 * MiB;
constexpr int CW_TMO = 0;
constexpr int CW_BAR = 4096;
constexpr int CW_CNT = 16384;
constexpr size_t WS_SSP = 12 * MiB;

constexpr int RING_BYTES = 131072;
constexpr int LDS_PHASE = 151552;
constexpr int LDS_TAB = LDS_PHASE;
constexpr int LDS_MISC = LDS_PHASE + 4096;
constexpr int LDS_WSCR = LDS_PHASE + 5120;
constexpr int LDS_BYTES = 163840;

__device__ __forceinline__ float bf2f(unsigned short u) { return __uint_as_float((unsigned)u << 16); }
__device__ __forceinline__ float bflo(unsigned u) { return __uint_as_float(u << 16); }
__device__ __forceinline__ float bfhi(unsigned u) { return __uint_as_float(u & 0xffff0000u); }
__device__ __forceinline__ unsigned f2bf(float f) { unsigned u = __builtin_bit_cast(unsigned, f); return (u + 0x7fffu + ((u >> 16) & 1u)) >> 16; }
__device__ __forceinline__ unsigned pk2(float lo, float hi) { return f2bf(lo) | (f2bf(hi) << 16); }
__device__ __forceinline__ float wave_sum(float v) {
#pragma unroll
    for (int o = 1; o < 64; o <<= 1) v += __shfl_xor(v, o);
    return v;
}
__device__ __forceinline__ float wave_max(float v) {
#pragma unroll
    for (int o = 1; o < 64; o <<= 1) v = fmaxf(v, __shfl_xor(v, o));
    return v;
}
#define LDS_WAIT() asm volatile("s_waitcnt lgkmcnt(0)" ::: "memory")
#define VM_WAIT() asm volatile("s_waitcnt vmcnt(0)" ::: "memory")

namespace pg8 {
#define PG8_LAS __attribute__((address_space(3)))
constexpr int BM = 256, BK = 64, HALF = 128, HTB = HALF * BK * 2, STAGE_BYTES = 8 * HTB, NXCD = 8, WGM = 8;
__host__ __device__ __forceinline__ int lds_byte(int r, int c) { const int st = (r >> 4) * 2 + (c >> 5), rr = r & 15, cc = c & 31, ob = rr * 64 + cc * 2; return st * 1024 + (ob ^ (((ob >> 9) & 1) << 5)); }
__host__ __device__ __forceinline__ void stage_rc(int b, int& R, int& C) { const int st = b / 1024, sb = b % 1024, swz = sb ^ (((sb >> 9) & 1) << 5); R = (st >> 1) * 16 + swz / 64; C = (st & 1) * 32 + (swz % 64) / 2; }
__host__ __device__ __forceinline__ int perm32(int rho) { const int n = rho >> 4, i = rho & 15; return 8 * (i >> 2) + 4 * n + (i & 3); }

struct Unit { int pm, pn, e, l0, cnt, mh; };

__device__ __forceinline__ unsigned cvt_pk_bf16(float lo, float hi) { unsigned r; asm volatile("v_cvt_pk_bf16_f32 %0, %1, %2" : "=v"(r) : "v"(lo), "v"(hi)); return r; }

struct PlainSched {
    int nM, nN, nwg, G, c, K; const char* Bt;
    __device__ void init(int M, int N, int K_, int G_, int c_, const void* Bt_) { nM = M / BM; nN = N / BM; nwg = nM * nN; G = G_; c = c_; K = K_; Bt = (const char*)Bt_; }
    __device__ __forceinline__ bool next(int i, Unit& u) const {
        const long L = (long)i * G + c; if (L >= nwg) return false;
        int wgid = (int)L; { const int q = nwg / NXCD, r = nwg % NXCD, xcd = wgid % NXCD, off = wgid / NXCD; wgid = (xcd < r ? xcd * (q + 1) : r * (q + 1) + (xcd - r) * q) + off; }
        const int nig = WGM * nN, gid = wgid / nig, fm = gid * WGM, gsz = (nM - fm) < WGM ? (nM - fm) : WGM;
        u.pm = fm + ((wgid % nig) % gsz); u.pn = (wgid % nig) / gsz; u.e = 0; u.l0 = 0; u.cnt = 256; u.mh = -1; return true;
    }
    __device__ __forceinline__ int a_row(const Unit& u, int r) const { return u.pm * BM + r; }
    __device__ __forceinline__ unsigned a_off2(const Unit&, int, int row) const { return (unsigned)row * (unsigned)(K * 2); }
    __device__ __forceinline__ const char* b_ptr(const Unit& u) const { return Bt + (size_t)u.pn * BM * K * 2; }
};
template <bool GATHER> struct MoeSched {
    int G, c, T, K; const PG8_LAS int* tab; const int* tokl; const char* W; size_t wexp;
    __device__ __forceinline__ bool next(int i, Unit& u) const {
        int mt, pn, mh = -1;
        if (G == 256) { const int R = T >> 6, rem = T & 63;
            if (i == R && rem <= 32) { const int m = c >> 3, sub = c & 7; if (m >= rem) return false; mt = 64 * R + m; pn = sub >> 1; mh = sub & 1; }
            else { const int x = c & 7, j = c >> 3; mt = i * 64 + x * 8 + (j >> 2); pn = j & 3; } }
        else { const int L = i * G + c; mt = L >> 2; pn = L & 3; }
        if (mt >= T) return false;
        int l0 = tab[3 * mt + 1], cnt = tab[3 * mt + 2];
        if (mh >= 0) { if (mh) { l0 += HALF; cnt -= HALF; } else cnt = cnt < HALF ? cnt : HALF; if (cnt <= 0) return false; }
        u.pm = mt; u.pn = pn; u.mh = mh; u.e = tab[3 * mt]; u.l0 = l0; u.cnt = cnt; return true;
    }
    __device__ __forceinline__ int a_row(const Unit& u, int r) const { if (GATHER) return tokl[u.l0 + ((r < u.cnt) ? r : 0)]; return u.pm * BM + (u.mh > 0 ? HALF : 0) + r; }
    __device__ __forceinline__ unsigned a_off2(const Unit& u, int r, int row) const { if (GATHER) return (r < u.cnt) ? (unsigned)row * (unsigned)(K * 2) : 0u; return (unsigned)row * (unsigned)(K * 2); }
    __device__ __forceinline__ const char* b_ptr(const Unit& u) const { return W + (size_t)u.e * wexp + (size_t)u.pn * BM * K * 2; }
};

struct EpiProj {
    static constexpr bool PERM = true, MIDSCALE = false;
    bf16_t* O; int ldc; float qscale; const float* rs1;
    __device__ __forceinline__ void operator()(const f32x4 (&acc)[2][2][4][2], const Unit& u, int wr, int wc, int fr, int fq) const {
        const int row0 = u.pm * BM + wr * 64 + fr, col0 = u.pn * BM + wc * 32 + 8 * fq;
        const float sc0 = (u.pn < 2) ? qscale : 1.f;
        float rsc[2][4];
#pragma unroll
        for (int ai = 0; ai < 2; ++ai)
#pragma unroll
            for (int m = 0; m < 4; ++m) rsc[ai][m] = rs1[row0 + ai * HALF + m * 16];
#pragma unroll
        for (int ai = 0; ai < 2; ++ai)
#pragma unroll
            for (int m = 0; m < 4; ++m) { bf16_t* rowp = O + (size_t)(row0 + ai * HALF + m * 16) * ldc + col0; const float sc = sc0 * rsc[ai][m];
#pragma unroll
                for (int bj = 0; bj < 2; ++bj) { const f32x4 v0 = acc[ai][bj][m][0] * sc, v1 = acc[ai][bj][m][1] * sc;
                    u32x4 w; w.x = cvt_pk_bf16(v0[0], v0[1]); w.y = cvt_pk_bf16(v0[2], v0[3]); w.z = cvt_pk_bf16(v1[0], v1[1]); w.w = cvt_pk_bf16(v1[2], v1[3]);
                    *(u32x4*)(rowp + bj * HALF) = w; } }
    }
};
struct EpiRes {
    static constexpr bool PERM = true, MIDSCALE = true;
    const bf16_t* base; bf16_t* out; int ldc; float* ss2; const PG8_LAS float* rtab;
    __device__ __forceinline__ void midscale(f32x4 (&acc)[2][2][4][2], int ui, int wr, int fr) const {
#pragma unroll
        for (int ai = 0; ai < 2; ++ai)
#pragma unroll
            for (int m = 0; m < 4; ++m) { const float s = rtab[256 * ui + ai * HALF + wr * 64 + m * 16 + fr];
#pragma unroll
                for (int bj = 0; bj < 2; ++bj)
#pragma unroll
                    for (int n = 0; n < 2; ++n) acc[ai][bj][m][n] = acc[ai][bj][m][n] * s; }
    }
    __device__ __forceinline__ void operator()(const f32x4 (&acc)[2][2][4][2], const Unit& u, int wr, int wc, int fr, int fq) const {
        const int row0 = u.pm * BM + wr * 64 + fr, col0 = u.pn * BM + wc * 32 + 8 * fq;
        u32x4 pre[2][4][2];
#pragma unroll
        for (int ai = 0; ai < 2; ++ai)
#pragma unroll
            for (int m = 0; m < 4; ++m) { const size_t off = (size_t)(row0 + ai * HALF + m * 16) * ldc + col0;
#pragma unroll
                for (int bj = 0; bj < 2; ++bj) pre[ai][m][bj] = *(const u32x4*)(base + off + bj * HALF); }
#pragma unroll
        for (int ai = 0; ai < 2; ++ai) {
#pragma unroll
            for (int m = 0; m < 4; ++m) { const int row = row0 + ai * HALF + m * 16; const size_t off = (size_t)row * ldc + col0; float ss = 0.f;
#pragma unroll
                for (int bj = 0; bj < 2; ++bj) { const u32x4 pb_ = pre[ai][m][bj]; const f32x4 b0 = (f32x4){bflo(pb_.x), bfhi(pb_.x), bflo(pb_.y), bfhi(pb_.y)}, b1 = (f32x4){bflo(pb_.z), bfhi(pb_.z), bflo(pb_.w), bfhi(pb_.w)};
                    const f32x4 o0 = b0 + acc[ai][bj][m][0], o1 = b1 + acc[ai][bj][m][1];
                    u32x4 w; w.x = cvt_pk_bf16(o0.x, o0.y); w.y = cvt_pk_bf16(o0.z, o0.w); w.z = cvt_pk_bf16(o1.x, o1.y); w.w = cvt_pk_bf16(o1.z, o1.w);
                    *(u32x4*)(out + off + bj * HALF) = w;
                    ss += (o0.x * o0.x + o0.y * o0.y) + (o0.z * o0.z + o0.w * o0.w) + (o1.x * o1.x + o1.y * o1.y) + (o1.z * o1.z + o1.w * o1.w); }
                ss += __shfl_xor(ss, 16); ss += __shfl_xor(ss, 32);
                if (fq == 0) ss2[(size_t)(u.pn * 4 + wc) * NTOK + row] = ss; } }
    }
};
__device__ __forceinline__ float silu_f(float g) { return g * __builtin_amdgcn_rcpf(1.f + __builtin_amdgcn_exp2f(-g * LOG2E)); }
__device__ __forceinline__ unsigned pk4_fp8(float a, float b, float c, float d) { int p = 0; p = __builtin_amdgcn_cvt_pk_fp8_f32(a, b, p, false); p = __builtin_amdgcn_cvt_pk_fp8_f32(c, d, p, true); return (unsigned)p; }
struct EpiGU {
    static constexpr bool PERM = true, MIDSCALE = false;
    unsigned char* Hd;
    __device__ __forceinline__ void operator()(const f32x4 (&acc)[2][2][4][2], const Unit& u, int wr, int wc, int fr, int fq) const {
        const int row0 = u.pm * BM + (u.mh > 0 ? HALF : 0) + wr * 64 + fr, col0 = u.pn * HALF + wc * 32 + 8 * fq;
#pragma unroll
        for (int ai = 0; ai < 2; ++ai) { if (ai == 1 && u.mh >= 0) continue;
#pragma unroll
            for (int m = 0; m < 4; ++m) { unsigned char* rowp = Hd + (size_t)(row0 + ai * HALF + m * 16) * DEXP + col0;
                const f32x4 g0 = acc[ai][0][m][0], g1 = acc[ai][0][m][1], u0 = acc[ai][1][m][0], u1 = acc[ai][1][m][1];
                u32x2 w; w.x = pk4_fp8(silu_f(g0[0]) * u0[0], silu_f(g0[1]) * u0[1], silu_f(g0[2]) * u0[2], silu_f(g0[3]) * u0[3]);
                w.y = pk4_fp8(silu_f(g1[0]) * u1[0], silu_f(g1[1]) * u1[1], silu_f(g1[2]) * u1[2], silu_f(g1[3]) * u1[3]);
                *(u32x2*)rowp = w; } }
    }
};
struct EpiDown {
    static constexpr bool PERM = true, MIDSCALE = false;
    unsigned char* Y; const float* gatel;
    __device__ __forceinline__ void operator()(const f32x4 (&acc)[2][2][4][2], const Unit& u, int wr, int wc, int fr, int fq) const {
        const int r0 = wr * 64 + fr, col0 = u.pn * BM + wc * 32 + 8 * fq;
        float gts[2][4];
#pragma unroll
        for (int ai = 0; ai < 2; ++ai)
#pragma unroll
            for (int m = 0; m < 4; ++m) { const int r = r0 + ai * HALF + m * 16; gts[ai][m] = gatel[u.l0 + ((r < u.cnt) ? r : 0)]; }
        asm volatile("" : "+v"(gts[0][0]), "+v"(gts[0][1]), "+v"(gts[0][2]), "+v"(gts[0][3]), "+v"(gts[1][0]), "+v"(gts[1][1]), "+v"(gts[1][2]), "+v"(gts[1][3]));
#pragma unroll
        for (int ai = 0; ai < 2; ++ai)
#pragma unroll
            for (int m = 0; m < 4; ++m) { const int r = r0 + ai * HALF + m * 16; gts[ai][m] = (r < u.cnt) ? 16.f * gts[ai][m] : 0.f; }
#pragma unroll
        for (int ai = 0; ai < 2; ++ai) { if (ai == 1 && u.mh >= 0) continue;
#pragma unroll
            for (int m = 0; m < 4; ++m) { const int r = r0 + ai * HALF + m * 16; const float gt = gts[ai][m];
                unsigned char* rowp = Y + (size_t)(u.pm * BM + (u.mh > 0 ? HALF : 0) + r) * DM + col0;
#pragma unroll
                for (int bj = 0; bj < 2; ++bj) { const f32x4 v0 = acc[ai][bj][m][0] * gt, v1 = acc[ai][bj][m][1] * gt;
                    u32x2 w; w.x = pk4_fp8(v0[0], v0[1], v0[2], v0[3]); w.y = pk4_fp8(v1[0], v1[1], v1[2], v1[3]);
                    *(u32x2*)(rowp + bj * HALF) = w; } } }
    }
};

typedef int v8i_t __attribute__((ext_vector_type(8)));
constexpr int FP8_SCALE_W = 0x7A7A7A7A, FP8_SCALE_X = 0x7F7F7F7F;

struct Frag16 { bf16x8 k[2]; };
__device__ __forceinline__ void ldfrag(Frag16& d, const PG8_LAS unsigned char* p) { d.k[0] = *(const PG8_LAS bf16x8*)p; d.k[1] = *(const PG8_LAS bf16x8*)(p + 1024); }
__device__ __forceinline__ void ldfrag(v8i_t& d, const PG8_LAS unsigned char* p) { typedef int v4i_t __attribute__((ext_vector_type(4))); const v4i_t lo = *(const PG8_LAS v4i_t*)p, hi = *(const PG8_LAS v4i_t*)(p + 16);
    d = __builtin_shufflevector(lo, hi, 0, 1, 2, 3, 4, 5, 6, 7); }
__device__ __forceinline__ void mmafrag(f32x4& c, const Frag16& b, const Frag16& a) { c = __builtin_amdgcn_mfma_f32_16x16x32_bf16(b.k[0], a.k[0], c, 0, 0, 0); c = __builtin_amdgcn_mfma_f32_16x16x32_bf16(b.k[1], a.k[1], c, 0, 0, 0); }
__device__ __forceinline__ void mmafrag(f32x4& c, const v8i_t& b, const v8i_t& a) {
    asm volatile("s_nop 1\n\tv_mfma_scale_f32_16x16x128_f8f6f4 %0, %1, %2, %0, %3, %4 op_sel_hi:[0,0,0]" : "+v"(c) : "v"(b), "v"(a), "v"(FP8_SCALE_W), "v"(FP8_SCALE_X)); }
template <bool FP8> struct FragT { typedef Frag16 T; };
template <> struct FragT<true> { typedef v8i_t T; };
template <class Epi, class Sched, bool ALIGN_EPI, bool FP8 = false>
__device__ __forceinline__ void gemm_phase(PG8_LAS unsigned char* lds, const void* Abase, const int K, const Sched& S, const Epi& E) {
    const int tid = threadIdx.x, wid = __builtin_amdgcn_readfirstlane(tid >> 6), lane = tid & 63, wr = wid >> 2, wc = wid & 3, fr = lane & 15, fq = lane >> 4;
    const int nt = K / BK;
    unsigned voffB[2];
#pragma unroll
    for (int i = 0; i < 2; ++i) { int R, C; stage_rc(tid * 16 + i * 8192, R, C); const int Rb = Epi::PERM ? ((R & ~31) + perm32(R & 31)) : R; voffB[i] = (unsigned)(Rb * K + C) * 2u; }
    const size_t kstep = (size_t)(BK * 2);
    const size_t hstepB = (size_t)HALF * K * 2;
    const unsigned ldsw = (unsigned)wid * 1024u;
    const int aoff = lds_byte(wr * 64 + fr, fq * (FP8 ? 16 : 8)), boff = lds_byte(wc * 32 + fr, fq * (FP8 ? 16 : 8));
#define PG8_SA(b, h) (((b) * 2 + (h)) * HTB)
#define PG8_SB(b, h) ((4 + (b) * 2 + (h)) * HTB)
#define PG8_STAGE(bufoff, gbase, voff) do { _Pragma("unroll") for (int _i = 0; _i < 2; ++_i) \
        __builtin_amdgcn_global_load_lds((const unsigned*)((const char*)(gbase) + (voff)[_i]), (PG8_LAS unsigned*)(lds + (bufoff) + ldsw + _i * 8192), 16, 0, 0); } while (0)
#define PG8_AOFF(dst, u) do { int t_[2][2]; _Pragma("unroll") for (int _i = 0; _i < 2; ++_i) { int R_, C_; stage_rc(tid * 16 + _i * 8192, R_, C_); \
        _Pragma("unroll") for (int _h = 0; _h < 2; ++_h) t_[_h][_i] = S.a_row(u, _h * HALF + R_); } \
        asm volatile("" : "+v"(t_[0][0]), "+v"(t_[0][1]), "+v"(t_[1][0]), "+v"(t_[1][1]));     \
        _Pragma("unroll") for (int _i = 0; _i < 2; ++_i) { int R_, C_; stage_rc(tid * 16 + _i * 8192, R_, C_); \
        _Pragma("unroll") for (int _h = 0; _h < 2; ++_h) dst[_h][_i] = S.a_off2(u, _h * HALF + R_, t_[_h][_i]) + (unsigned)C_ * 2u; } } while (0)
#define PG8_CAT8(lo, hi) __builtin_bit_cast(v8i_t, __builtin_shufflevector(lo, hi, 0, 1, 2, 3, 4, 5, 6, 7, 8, 9, 10, 11, 12, 13, 14, 15))
#define PG8_LDA(dst, b, h) do { _Pragma("unroll") for (int m = 0; m < 4; ++m) ldfrag(dst[m], lds + PG8_SA(b, h) + aoff + m * 2048); } while (0)
#define PG8_LDB(dst, b, h) do { _Pragma("unroll") for (int n = 0; n < 2; ++n) ldfrag(dst[n], lds + PG8_SB(b, h) + boff + n * 2048); } while (0)
#define PG8_MMA(ai, bj, At, Bt) do { __builtin_amdgcn_s_setprio(1); _Pragma("unroll") for (int m = 0; m < 4; ++m) _Pragma("unroll") for (int n = 0; n < 2; ++n) mmafrag(acc[ai][bj][m][n], Bt[n], At[m]); \
        __builtin_amdgcn_s_setprio(0); } while (0)
#define PG8_WAIT_V(n) asm volatile("s_waitcnt vmcnt(" #n ")" ::: "memory")
#define PG8_WAIT_L(n) asm volatile("s_waitcnt lgkmcnt(" #n ")" ::: "memory")
#define PG8_BAR __builtin_amdgcn_s_barrier()
#define PG8_SCHED __builtin_amdgcn_sched_barrier(0)
    Unit cur, nxt; int ui = 0;
    if (!S.next(0, cur)) return;
    f32x4 acc[2][2][4][2];
#pragma unroll
    for (int a = 0; a < 2; ++a)
#pragma unroll
        for (int b = 0; b < 2; ++b)
#pragma unroll
            for (int m = 0; m < 4; ++m)
#pragma unroll
                for (int n = 0; n < 2; ++n) acc[a][b][m][n] = (f32x4){0.f, 0.f, 0.f, 0.f};
    typename FragT<FP8>::T At[4], B0[2], B1[2];
    unsigned vC[2][2], vN[2][2];
    PG8_AOFF(vC, cur);
    const char* const Ab = (const char*)Abase;
    const char* cB = S.b_ptr(cur);
    PG8_STAGE(PG8_SB(0, 0), cB, voffB); PG8_STAGE(PG8_SB(0, 1), cB + hstepB, voffB); PG8_STAGE(PG8_SA(0, 0), Ab, vC[0]); PG8_STAGE(PG8_SA(0, 1), Ab, vC[1]);
    if (wr == 1) PG8_BAR;
    PG8_WAIT_V(2); PG8_BAR;
    PG8_STAGE(PG8_SB(1, 0), cB + kstep, voffB); PG8_STAGE(PG8_SA(1, 0), Ab + kstep, vC[0]); PG8_STAGE(PG8_SB(1, 1), cB + hstepB + kstep, voffB);
    PG8_WAIT_V(6); PG8_BAR;
    for (;;) {
        const bool has_next = S.next(ui + 1, nxt);
        const char* nB = has_next ? S.b_ptr(nxt) : cB;
        if (has_next) { PG8_AOFF(vN, nxt); }
        else {
#pragma unroll
            for (int h = 0; h < 2; ++h)
#pragma unroll
                for (int i = 0; i < 2; ++i) vN[h][i] = vC[h][i]; }
        const bool fullM = __builtin_amdgcn_readfirstlane(cur.mh) < 0;
        for (int t = 0; t < nt; t += 2) {
            if constexpr (Epi::MIDSCALE) { if (t == nt / 2) E.midscale(acc, ui, wr, fr); }
            const bool last = (t == nt - 2);
            const char* a1 = Ab + (size_t)(t + 1) * kstep;
            const char* a2 = last ? Ab : Ab + (size_t)(t + 2) * kstep; const char* b2 = last ? nB : cB + (size_t)(t + 2) * kstep;
            const char* a3 = a2 + kstep; const char* b3 = b2 + kstep;
            unsigned v2[2][2];
#pragma unroll
            for (int h = 0; h < 2; ++h)
#pragma unroll
                for (int i = 0; i < 2; ++i) v2[h][i] = last ? vN[h][i] : vC[h][i];
            PG8_LDB(B0, 0, 0); PG8_LDB(B1, 0, 1); PG8_SCHED; PG8_LDA(At, 0, 0); PG8_STAGE(PG8_SA(1, 1), a1, vC[1]);
            PG8_WAIT_V(8); PG8_WAIT_L(0); PG8_BAR; PG8_MMA(0, 0, At, B0); PG8_MMA(0, 1, At, B1); PG8_BAR; PG8_SCHED;
            if (fullM) { PG8_LDA(At, 0, 1); } PG8_STAGE(PG8_SB(0, 0), b2, voffB); PG8_STAGE(PG8_SB(0, 1), b2 + hstepB, voffB); PG8_STAGE(PG8_SA(0, 0), a2, v2[0]);
            PG8_WAIT_V(8); PG8_WAIT_L(0); PG8_BAR; if (fullM) { PG8_MMA(1, 0, At, B0); PG8_MMA(1, 1, At, B1); } PG8_BAR; PG8_SCHED;
            PG8_LDB(B0, 1, 0); PG8_LDB(B1, 1, 1); PG8_SCHED; PG8_LDA(At, 1, 0); PG8_STAGE(PG8_SA(0, 1), a2, v2[1]);
            PG8_WAIT_V(8); PG8_WAIT_L(0); PG8_BAR; PG8_MMA(0, 0, At, B0); PG8_MMA(0, 1, At, B1); PG8_BAR; PG8_SCHED;
            if (fullM) { PG8_LDA(At, 1, 1); } PG8_STAGE(PG8_SB(1, 0), b3, voffB); PG8_STAGE(PG8_SB(1, 1), b3 + hstepB, voffB); PG8_STAGE(PG8_SA(1, 0), a3, v2[0]);
            PG8_WAIT_V(8); PG8_WAIT_L(0); PG8_BAR; if (fullM) { PG8_MMA(1, 0, At, B0); PG8_MMA(1, 1, At, B1); } PG8_BAR; PG8_SCHED;
        }
        if constexpr (ALIGN_EPI) { if (wr == 0) PG8_BAR; }
        if constexpr (FP8) asm volatile("s_nop 15\n\ts_nop 15" ::: "memory");
        E(acc, cur, wr, wc, fr, fq);
        if (!has_next) break;
#pragma unroll
        for (int a = 0; a < 2; ++a)
#pragma unroll
            for (int b = 0; b < 2; ++b)
#pragma unroll
                for (int m = 0; m < 4; ++m)
#pragma unroll
                    for (int n = 0; n < 2; ++n) acc[a][b][m][n] = (f32x4){0.f, 0.f, 0.f, 0.f};
        cur = nxt; cB = nB; ++ui;
#pragma unroll
        for (int h = 0; h < 2; ++h)
#pragma unroll
            for (int i = 0; i < 2; ++i) vC[h][i] = vN[h][i];
        if constexpr (ALIGN_EPI) { if (wr == 1) PG8_BAR; }
    }
    PG8_WAIT_V(0);
    if constexpr (!ALIGN_EPI) { if (wr == 0) PG8_BAR; }
    PG8_BAR;
#undef PG8_SA
#undef PG8_SB
#undef PG8_STAGE
#undef PG8_AOFF
#undef PG8_LDA
#undef PG8_LDB
#undef PG8_MMA
#undef PG8_CAT8
#undef PG8_WAIT_V
#undef PG8_WAIT_L
#undef PG8_BAR
#undef PG8_SCHED
}
}

#define XB_TMO      128
#define XB_XCNT(j)  (256  + 64 * (j))
#define XB_XSUB(j)  (1280 + 64 * (j))
#define XB_XGEN(j)  (2304 + 64 * (j))
#define XB_TOP      3328
#define XB_TOPGEN   3392
#define XCD_BAR_WORDS 3456
#define XB_SPIN_CAP (1u << 18)
__device__ __forceinline__ unsigned xb_ld(unsigned* p)              { return __hip_atomic_load(p, __ATOMIC_RELAXED, __HIP_MEMORY_SCOPE_AGENT); }
__device__ __forceinline__ unsigned xb_add(unsigned* p, unsigned v) { return __hip_atomic_fetch_add(p, v, __ATOMIC_RELAXED, __HIP_MEMORY_SCOPE_AGENT); }
__device__ __forceinline__ unsigned xb_xcc_id() { return (unsigned)__builtin_amdgcn_s_getreg((3 << 11) | 20) & 0xFu; }
#define XB_SPIN(cond, bar) do { unsigned _sp = 0; while (cond) { __builtin_amdgcn_s_sleep(1); \
    if ((++_sp & 255u) == 0u) { if (xb_ld(&(bar)[XB_TMO])) break; if (_sp > XB_SPIN_CAP) { atomicAdd(&(bar)[XB_TMO], 1u); break; } } } } while (0)
struct XcdBarrier { unsigned* bar; unsigned x; volatile LAS unsigned* st; };
__device__ __forceinline__ XcdBarrier xcd_barrier_post(unsigned* bar, volatile LAS unsigned* st) {
    XcdBarrier b; b.bar = bar; b.x = xb_xcc_id(); b.st = st;
    if (threadIdx.x == 0) (void)xb_add(&bar[XB_XCNT(b.x)], 1u);
    return b;
}
__device__ __forceinline__ void xcd_barrier_complete(unsigned* bar, unsigned x, unsigned& nloc, unsigned& nx) {
    const unsigned G = gridDim.x * gridDim.y * gridDim.z;
    unsigned sum, cnt, mine, sp = 0u;
    for (;;) {
        sum = 0u; cnt = 0u; mine = 0u;
#pragma unroll
        for (unsigned j = 0; j < 16; ++j) { const unsigned c = xb_ld(&bar[XB_XCNT(j)]); sum += c; cnt += (c > 0u) ? 1u : 0u; mine = (j == x) ? c : mine; }
        if (sum == G) break;
        __builtin_amdgcn_s_sleep(1);
        if ((++sp & 255u) == 0u) { if (xb_ld(&bar[XB_TMO])) break; if (sp > XB_SPIN_CAP) { atomicAdd(&bar[XB_TMO], 1u); break; } }
    }
    nloc = mine > 0u ? mine : 1u; nx = cnt > 0u ? cnt : 1u;
}
__device__ __forceinline__ void xcd_barrier(const XcdBarrier& b) {
    asm volatile("s_waitcnt vmcnt(0)" ::: "memory");
    __syncthreads();
    if (threadIdx.x == 0) {
        unsigned* bar = b.bar;
        __builtin_amdgcn_s_waitcnt(0);
        unsigned nloc = b.st[0], nx = b.st[1];
        if (nloc == 0u) { xcd_barrier_complete(bar, b.x, nloc, nx); b.st[0] = nloc; b.st[1] = nx; }
        const unsigned old = xb_add(&bar[XB_XSUB(b.x)], 1u);
        const unsigned gen = old / nloc;
        if (old + 1u == (gen + 1u) * nloc) {
            __builtin_amdgcn_fence(__ATOMIC_RELEASE, "agent");
            asm volatile("s_waitcnt vmcnt(0)" ::: "memory");
            const unsigned og = xb_add(&bar[XB_TOP], 1u);
            const unsigned tg = og / nx;
            if (og + 1u == (tg + 1u) * nx) xb_add(&bar[XB_TOPGEN], 1u);
            else XB_SPIN(xb_ld(&bar[XB_TOPGEN]) == tg, bar);
            __builtin_amdgcn_fence(__ATOMIC_ACQUIRE, "agent");
            xb_add(&bar[XB_XGEN(b.x)], 1u);
            asm volatile("s_waitcnt vmcnt(0)" ::: "memory");
        } else {
            XB_SPIN(xb_ld(&bar[XB_XGEN(b.x)]) == gen, bar);
            __builtin_amdgcn_fence(__ATOMIC_ACQUIRE, "agent");
            asm volatile("s_waitcnt vmcnt(0)" ::: "memory");
        }
    }
    __syncthreads();
}

struct Ctx {
    LAS unsigned char* lds; int tid, lane, wave, vcu, G;
    const float* in[16]; float* out; unsigned char* ws;
};

__device__ __forceinline__ void p0_transpose_item(const float* W, int K, int N, bf16* WT, int k0, int n0, int drow0, LAS float* scr, int lane, const float* kgain = nullptr) {
    const int kr = lane >> 3, c4 = lane & 7;
    f32x4 w[8];
#pragma unroll
    for (int i = 0; i < 8; ++i) w[i] = *(const f32x4*)(W + (size_t)(k0 + kr + 8 * i) * N + n0 + 4 * c4);
    if (kgain) {
#pragma unroll
        for (int i = 0; i < 8; ++i) w[i] = w[i] * kgain[k0 + kr + 8 * i]; }
#pragma unroll
    for (int i = 0; i < 8; ++i) { LAS float* d = scr + (kr + 8 * i) * 33 + 4 * c4; d[0] = w[i].x; d[1] = w[i].y; d[2] = w[i].z; d[3] = w[i].w; }
    LDS_WAIT(); asm volatile("" ::: "memory");
    const int c = lane & 7;
#pragma unroll
    for (int j = 0; j < 4; ++j) { const int n = (lane >> 3) + 8 * j; const LAS float* s = scr + (8 * c) * 33 + n;
        u32x4 o; o.x = pk2(s[0 * 33], s[1 * 33]); o.y = pk2(s[2 * 33], s[3 * 33]); o.z = pk2(s[4 * 33], s[5 * 33]); o.w = pk2(s[6 * 33], s[7 * 33]);
        *(GAS u32x4*)(WT + (size_t)(drow0 + n) * K + k0 + 8 * c) = o; }
    LDS_WAIT(); asm volatile("" ::: "memory");
}
__device__ __forceinline__ void p0_transpose_item_fp8(const float* W, int K, int N, unsigned char* WT, int k0, int n0, int drow0, LAS float* scr, int lane) {
    const int kr = lane >> 3, c4 = lane & 7;
    f32x4 w[8];
#pragma unroll
    for (int i = 0; i < 8; ++i) w[i] = *(const f32x4*)(W + (size_t)(k0 + kr + 8 * i) * N + n0 + 4 * c4);
#pragma unroll
    for (int i = 0; i < 8; ++i) { LAS float* d = scr + (kr + 8 * i) * 33 + 4 * c4; d[0] = w[i].x * 32.f; d[1] = w[i].y * 32.f; d[2] = w[i].z * 32.f; d[3] = w[i].w * 32.f; }
    LDS_WAIT(); asm volatile("" ::: "memory");
    const int q = lane & 3;
#pragma unroll
    for (int j = 0; j < 2; ++j) { const int n = (lane >> 2) + 16 * j; const LAS float* s = scr + (16 * q) * 33 + n;
        u32x4 o; o.x = pg8::pk4_fp8(s[0 * 33], s[1 * 33], s[2 * 33], s[3 * 33]); o.y = pg8::pk4_fp8(s[4 * 33], s[5 * 33], s[6 * 33], s[7 * 33]);
        o.z = pg8::pk4_fp8(s[8 * 33], s[9 * 33], s[10 * 33], s[11 * 33]); o.w = pg8::pk4_fp8(s[12 * 33], s[13 * 33], s[14 * 33], s[15 * 33]);
        *(GAS u32x4*)(WT + (size_t)(drow0 + n) * K + k0 + 16 * q) = o; }
    LDS_WAIT(); asm volatile("" ::: "memory");
}
struct ConvItem { const float* W; unsigned char* WT; int K, N, k0, n0, drow0; };
__device__ __forceinline__ ConvItem moe_conv_desc(const Ctx& F, int r) {
    unsigned char* ws = F.ws; ConvItem c; const int e = r / 768; r -= e * 768;
    if (r < 256) { const int kb = r / 16, nb = r % 16, n0 = 32 * nb; c.W = F.in[12] + (size_t)e * DM * DEXP; c.WT = (unsigned char*)(ws + WS_WGU) + (size_t)e * DM * DM; c.K = DM; c.N = DEXP; c.k0 = 64 * kb; c.n0 = n0; c.drow0 = (n0 >> 7) * 256 + (n0 & 127); return c; } r -= 256;
    if (r < 256) { const int kb = r / 16, nb = r % 16, n0 = 32 * nb; c.W = F.in[13] + (size_t)e * DM * DEXP; c.WT = (unsigned char*)(ws + WS_WGU) + (size_t)e * DM * DM; c.K = DM; c.N = DEXP; c.k0 = 64 * kb; c.n0 = n0; c.drow0 = (n0 >> 7) * 256 + 128 + (n0 & 127); return c; } r -= 256;
    { const int kb = r / 32, nb = r % 32; c.W = F.in[14] + (size_t)e * DEXP * DM; c.WT = (unsigned char*)(ws + WS_WD) + (size_t)e * DM * DEXP; c.K = DEXP; c.N = DM; c.k0 = 64 * kb; c.n0 = 32 * nb; c.drow0 = 32 * nb; return c; }
}
__device__ __forceinline__ void moe_convert_pair(const Ctx& F, int r0, int r1, LAS float* scr, int lane_in) {
    int lane = lane_in; asm volatile("" : "+v"(lane));
    const ConvItem a = moe_conv_desc(F, r0), b = moe_conv_desc(F, r1);
    const int kr = lane >> 3, c4 = lane & 7;
    f32x4 wa[8], wb[8];
#pragma unroll
    for (int i = 0; i < 8; ++i) wa[i] = *(const f32x4*)(a.W + (size_t)(a.k0 + kr + 8 * i) * a.N + a.n0 + 4 * c4);
#pragma unroll
    for (int i = 0; i < 8; ++i) wb[i] = *(const f32x4*)(b.W + (size_t)(b.k0 + kr + 8 * i) * b.N + b.n0 + 4 * c4);
#pragma unroll
    for (int half = 0; half < 2; ++half) {
        const ConvItem& c = half ? b : a;
#pragma unroll
        for (int i = 0; i < 8; ++i) { const f32x4 w = half ? wb[i] : wa[i]; LAS float* d = scr + (kr + 8 * i) * 33 + 4 * c4; d[0] = w.x * 32.f; d[1] = w.y * 32.f; d[2] = w.z * 32.f; d[3] = w.w * 32.f; }
        LDS_WAIT(); asm volatile("" ::: "memory");
        const int q = lane & 3;
#pragma unroll
        for (int j = 0; j < 2; ++j) { const int n = (lane >> 2) + 16 * j; const LAS float* s = scr + (16 * q) * 33 + n;
            u32x4 o; o.x = pg8::pk4_fp8(s[0 * 33], s[1 * 33], s[2 * 33], s[3 * 33]); o.y = pg8::pk4_fp8(s[4 * 33], s[5 * 33], s[6 * 33], s[7 * 33]);
            o.z = pg8::pk4_fp8(s[8 * 33], s[9 * 33], s[10 * 33], s[11 * 33]); o.w = pg8::pk4_fp8(s[12 * 33], s[13 * 33], s[14 * 33], s[15 * 33]);
            *(GAS u32x4*)(c.WT + (size_t)(c.drow0 + n) * c.K + c.k0 + 16 * q) = o; }
        LDS_WAIT(); asm volatile("" ::: "memory");
    }
}
__device__ __forceinline__ void p0_prologue(const Ctx& F) {
    LAS float* scr = (LAS float*)(F.lds + F.wave * 16384);
    const int gw = F.vcu * NWAVES + F.wave, NGW = F.G * NWAVES;
    unsigned char* ws = F.ws;
    constexpr int I_IN = 16 * 112, I_OUT = 16 * 32, NITEMS = I_IN + I_OUT;
    for (int it = gw; it < NITEMS; it += NGW) {
        int r = it;
        if (r < I_IN) { const int kb = r / 112, nb = r % 112; p0_transpose_item(F.in[2], DM, NPROJ, (bf16*)(ws + WS_WIN), 64 * kb, 32 * nb, 32 * nb, scr, F.lane, F.in[1]); continue; } r -= I_IN;
        { const int kb = r / 32, nb = r % 32; p0_transpose_item(F.in[6], DM, DM, (bf16*)(ws + WS_WOUT), 64 * kb, 32 * nb, 32 * nb, scr, F.lane, kb < 8 ? F.in[3] : nullptr); }
    }
    { bf16* whi = (bf16*)(ws + WS_WRT); bf16* wlo = whi + 36 * DM; const int gt = F.vcu * NTHR + F.tid, NGT = F.G * NTHR;
      for (int idx = gt; idx < 36 * DM; idx += NGT) { const int o = idx / DM, k = idx % DM; const float w = F.in[7][k] * ((o < 4) ? F.in[8][k * 4 + o] : F.in[10][k * 32 + (o - 4)]);
          const unsigned h = f2bf(w); whi[idx] = (bf16)h; wlo[idx] = (bf16)f2bf(w - __uint_as_float(h << 16)); } }
    const float* x = F.in[0]; bf16* H = (bf16*)(ws + WS_H); float* rs1 = (float*)(ws + WS_SUMSQ);
    for (int m = gw; m < NTOK; m += NGW) {
        const GAS f32x4* xr = (const GAS f32x4*)(x + (size_t)m * DM) + F.lane;
        f32x4 v[4]; float s = 0.f;
#pragma unroll
        for (int j = 0; j < 4; ++j) { v[j] = xr[64 * j]; s += (v[j].x * v[j].x + v[j].y * v[j].y) + (v[j].z * v[j].z + v[j].w * v[j].w); }
        const float rstd = 1.f / sqrtf(wave_sum(s) * (1.f / DM) + EPS);
        if (F.lane == 0) rs1[m] = rstd;
        GAS unsigned long long* o8 = (GAS unsigned long long*)(H + (size_t)m * DM) + F.lane;
#pragma unroll
        for (int j = 0; j < 4; ++j) o8[64 * j] = (unsigned long long)pk2(v[j].x, v[j].y) | ((unsigned long long)pk2(v[j].z, v[j].w) << 32);
    }
}

namespace att {
typedef float f32x16 __attribute__((ext_vector_type(16)));
typedef short s16x4 __attribute__((ext_vector_type(4)));
typedef short v4i16_t __attribute__((ext_vector_type(4)));
typedef __attribute__((address_space(3))) const char* lds_cptr;
constexpr float NEGBIG = -1.0e30f, THR = 12.f;
__device__ __forceinline__ void glds16(const void* gsrc, unsigned lds_dst) { unsigned keep;
    asm volatile("s_mov_b32 %0, m0\n\ts_mov_b32 m0, %2\n\ts_nop 0\n\tglobal_load_lds_dwordx4 %1, off\n\ts_mov_b32 m0, %0" : "=&s"(keep) : "v"(gsrc), "s"(lds_dst) : "memory"); }
__device__ __forceinline__ s16x4 vtr(lds_cptr p) { return __builtin_bit_cast(s16x4, __builtin_amdgcn_ds_read_tr16_b64_v4i16((__attribute__((address_space(3))) v4i16_t*)p)); }
__device__ __forceinline__ float xmax32(float m) { auto rr = __builtin_amdgcn_permlane32_swap(__float_as_uint(m), __float_as_uint(m), false, false); return fmaxf(__uint_as_float(rr[0]), __uint_as_float(rr[1])); }
__device__ __forceinline__ float xsum32(float m) { auto rr = __builtin_amdgcn_permlane32_swap(__float_as_uint(m), __float_as_uint(m), false, false); return __uint_as_float(rr[0]) + __uint_as_float(rr[1]); }
__device__ __forceinline__ unsigned cvtpk(float lo, float hi) { typedef float f2 __attribute__((ext_vector_type(2))); typedef __bf16 b2 __attribute__((ext_vector_type(2))); f2 v = {lo, hi}; b2 b = __builtin_convertvector(v, b2); return __builtin_bit_cast(unsigned, b); }

struct Bufs { const bf16* proj; bf16* po16; float* pl16; bf16* po4; float* pl4; bf16* mix; float* sumsq; };

struct KVAddr { const char* kb0; const char* kb1; const char* vbp; size_t pstep, tstep; };
__device__ __forceinline__ KVAddr kv_addr(const char* pb, int h, int d, int r, int lane) {
    const size_t rowB = (size_t)PPITCH * 2; const int kl8 = lane >> 3, sw = lane >> 4; KVAddr A;
    const char* rowp = pb + (size_t)(kl8 * d + r) * rowB;
    A.kb0 = rowp + (C_K + h * 64) * 2 + (((lane & 7) ^ sw) * 16);
    A.kb1 = rowp + (C_K + h * 64) * 2 + (((lane & 7) ^ (4 + sw)) * 16);
    A.vbp = rowp + (C_V + h * 64) * 2 + (((lane & 7) ^ ((sw & 1) << 2)) * 16);
    A.pstep = (size_t)8 * d * rowB; A.tstep = (size_t)32 * d * rowB; return A; }
__device__ __forceinline__ void kv_dma(const KVAddr& A, int kt, unsigned lb_) {
    const size_t to_ = (size_t)kt * A.tstep;
    glds16(A.kb0 + to_, (unsigned)__builtin_amdgcn_readfirstlane(lb_)); glds16(A.kb1 + to_ + A.pstep, (unsigned)__builtin_amdgcn_readfirstlane(lb_ + 1024u));
    glds16(A.kb0 + to_ + 2 * A.pstep, (unsigned)__builtin_amdgcn_readfirstlane(lb_ + 2048u)); glds16(A.kb1 + to_ + 3 * A.pstep, (unsigned)__builtin_amdgcn_readfirstlane(lb_ + 3072u));
    glds16(A.vbp + to_, (unsigned)__builtin_amdgcn_readfirstlane(lb_ + 4096u)); glds16(A.vbp + to_ + A.pstep, (unsigned)__builtin_amdgcn_readfirstlane(lb_ + 5120u));
    glds16(A.vbp + to_ + 2 * A.pstep, (unsigned)__builtin_amdgcn_readfirstlane(lb_ + 6144u)); glds16(A.vbp + to_ + 3 * A.pstep, (unsigned)__builtin_amdgcn_readfirstlane(lb_ + 7168u)); }

template <int NQ> struct QPre { u32x4 qv[NQ][4]; };
__device__ __forceinline__ void prolog_dma(const Bufs& B, unsigned wl_addr, int b, int h, int d, int r, int u0, int lane_in, int slot) {
    int lane = lane_in; asm volatile("" : "+v"(lane));
    const size_t rowB = (size_t)PPITCH * 2; const char* pb = (const char*)B.proj + (size_t)b * SEQ * rowB;
    const KVAddr A = kv_addr(pb, h, d, r, lane);
    const int jA = u0 >> 5; const int kt0 = (jA - 4) > 0 ? (jA - 4) : 0;
    kv_dma(A, kt0, wl_addr + (unsigned)slot * 8192u);
}
template <int NQ>
__device__ __forceinline__ void prolog_q(const Bufs& B, int b, int h, int d, int r, int u0, int lane_in, QPre<NQ>& P) {
    int lane = lane_in; asm volatile("" : "+v"(lane));
    const size_t rowB = (size_t)PPITCH * 2; const char* pb = (const char*)B.proj + (size_t)b * SEQ * rowB;
    const int kl8 = lane >> 3;
#pragma unroll
    for (int x = 0; x < NQ; ++x)
#pragma unroll
        for (int p = 0; p < 4; ++p) P.qv[x][p] = *(const u32x4*)(pb + (size_t)((u0 + 32 * x + 8 * p + kl8) * d + r) * rowB + (C_Q + h * 64) * 2 + (lane & 7) * 16);
}
struct NoNext { static constexpr int NOPS = 0; __device__ __forceinline__ void dma(int) const {} __device__ __forceinline__ void qload() const {} };
template <int NQN> struct NextPro { const Bufs& B; unsigned wl_addr; int b, h, d, r, u0, lane; QPre<NQN>& P; static constexpr int NOPS = 8;
    __device__ __forceinline__ void dma(int slot) const { prolog_dma(B, wl_addr, b, h, d, r, u0, lane, slot); }
    __device__ __forceinline__ void qload() const { prolog_q<NQN>(B, b, h, d, r, u0, lane, P); } };

template <int NQ> struct Stash { u32x4 v[NQ][4]; float lse[NQ]; };
struct NoFlush { static constexpr int NST = 0; __device__ __forceinline__ void operator()() const {} };
template <int NQP> struct Flush { bf16* po; float* pl; int b, h, d, r, u0, lane; const Stash<NQP>& S; static constexpr int NST = 5 * NQP;
    __device__ __forceinline__ void operator()() const {
        int ln = lane; asm volatile("" : "+v"(ln));
        const int kl8 = ln >> 3, ch = ln & 7, i = ln & 31, hi = ln >> 5;
#pragma unroll
        for (int x = 0; x < NQP; ++x) {
#pragma unroll
            for (int p = 0; p < 4; ++p) { const int tokr = b * SEQ + (u0 + 32 * x + 8 * p + kl8) * d + r; *(u32x4*)(po + (size_t)tokr * POPITCH + h * 64 + ch * 8) = S.v[x][p]; }
            if (hi == 0) pl[(b * 8 + h) * SEQ + r * (SEQ / d) + u0 + 32 * x + i] = S.lse[x]; }
    } };

template <int NQ, int MODE, class Prev, class Next>
__device__ __forceinline__ int qgroup(const Bufs& B, lds_cptr wl, unsigned wl_addr, int b, int h, int d, int r, int u0, float slope2, int lane_in, QPre<NQ>& P, int s0, const Prev& prev, const Next& next, Stash<NQ>& out) {
    int lane = lane_in; asm volatile("" : "+v"(lane));
    constexpr int NST = Prev::NST;
    const int i = lane & 31, hi = lane >> 5;
    const size_t rowB = (size_t)PPITCH * 2;
    const char* pb = (const char*)B.proj + (size_t)b * SEQ * rowB;
    const float sld = slope2 * (float)d; const int iq = i - 4 * hi; const float bl = -sld * (float)(iq + 128);
    const int kl8 = lane >> 3, sw = lane >> 4;
    const KVAddr A = kv_addr(pb, h, d, r, lane);
    const int ksw = (i >> 1) & 7;
    int kaddr[4];
#pragma unroll
    for (int s = 0; s < 4; ++s) kaddr[s] = i * 128 + (((2 * s + hi) ^ ksw) * 16);
    const int g16 = lane >> 4, i16 = lane & 15, kbit = (i16 >> 3) & 1, vrow = 4 * hi + (i16 >> 2), vcol = 2 * (g16 & 1) + ((i16 & 3) >> 1), vb8 = (i16 & 1) * 8;
    const int va0 = 4096 + vrow * 128 + (vcol + 4 * kbit) * 16 + vb8, va1 = 4096 + vrow * 128 + (vcol + 4 * (1 - kbit)) * 16 + vb8;
    const int jA = u0 >> 5; const int kt0 = (jA - 4) > 0 ? (jA - 4) : 0, kt1 = jA + NQ - 1;
    f32x16 O[NQ][2]; float lsum[NQ], mrun[NQ];
#pragma unroll
    for (int x = 0; x < NQ; ++x) { lsum[x] = 0.f; mrun[x] = 0.f;
#pragma unroll
        for (int e = 0; e < 16; ++e) { O[x][0][e] = 0.f; O[x][1][e] = 0.f; } }
    bf16x8 qf[NQ][4];
    { typedef __attribute__((address_space(3))) unsigned char* lds_pq; const lds_pq qs = (lds_pq)wl + (s0 ^ 1) * 8192;
#pragma unroll
      for (int x = 0; x < NQ; ++x)
#pragma unroll
          for (int p = 0; p < 4; ++p) *(__attribute__((address_space(3))) u32x4*)(qs + x * 4096 + (8 * p + kl8) * 128 + (((lane & 7) ^ (4 * (p & 1) + sw)) * 16)) = P.qv[x][p];
      asm volatile("s_waitcnt lgkmcnt(0)" ::: "memory"); __builtin_amdgcn_wave_barrier();
#pragma unroll
      for (int x = 0; x < NQ; ++x)
#pragma unroll
          for (int s = 0; s < 4; ++s) qf[x][s] = *(const __attribute__((address_space(3))) bf16x8*)(qs + x * 4096 + kaddr[s]);
      asm volatile("s_waitcnt lgkmcnt(0)" ::: "memory"); __builtin_amdgcn_wave_barrier(); }
    if (kt0 < kt1) kv_dma(A, kt0 + 1, wl_addr + (unsigned)(s0 ^ 1) * 8192u); else next.dma(s0 ^ 1);
    prev();
    for (int kt = kt0; kt <= kt1; ++kt) {
        const int slot = ((kt - kt0) & 1) ^ s0;
        if (kt > kt0) { if (kt < kt1) kv_dma(A, kt + 1, wl_addr + (unsigned)(slot ^ 1) * 8192u); else next.dma(slot ^ 1); }
        if (kt < kt1 || Next::NOPS == 8) { if (kt - kt0 < 2) asm volatile("s_waitcnt vmcnt(%0)" :: "n"(8 + NST) : "memory"); else asm volatile("s_waitcnt vmcnt(8)" ::: "memory"); }
        else { if (kt - kt0 < 2) asm volatile("s_waitcnt vmcnt(%0)" :: "n"(NST) : "memory"); else asm volatile("s_waitcnt vmcnt(0)" ::: "memory"); }
        const lds_cptr sl = wl + slot * 8192;
        bf16x8 kf[4];
#pragma unroll
        for (int s = 0; s < 4; ++s) kf[s] = *(const __attribute__((address_space(3))) bf16x8*)(sl + kaddr[s]);
        bf16x8 vf[2][2];
#pragma unroll
        for (int ks = 0; ks < 2; ++ks) {
            const s16x4 a0 = vtr(sl + va0 + 2048 * ks), a1 = vtr(sl + va0 + 2048 * ks + 1024), b0 = vtr(sl + va1 + 2048 * ks), b1 = vtr(sl + va1 + 2048 * ks + 1024);
            vf[0][ks] = (bf16x8){a0[0], a0[1], a0[2], a0[3], a1[0], a1[1], a1[2], a1[3]};
            vf[1][ks] = (bf16x8){b0[0], b0[1], b0[2], b0[3], b1[0], b1[1], b1[2], b1[3]}; }
#pragma unroll
        for (int x = 0; x < NQ; ++x) {
            const int c = kt - (jA + x - 4);
            if (c >= 0 && c <= 4) {
                const int ktf = (jA + x - 4) > 0 ? (jA + x - 4) : 0;
                const bool first = (kt == ktf);
                const float base = bl + sld * (float)(32 * c) - (first ? 0.f : mrun[x]);
                f32x16 S;
#pragma unroll
                for (int e = 0; e < 16; ++e) S[e] = base + sld * (float)((e & 3) + 8 * (e >> 2));
                if (c == 0) {
#pragma unroll
                    for (int e = 0; e < 16; ++e) S[e] = (((e & 3) + 8 * (e >> 2)) >= iq) ? S[e] : NEGBIG; }
                if (c == 4) {
#pragma unroll
                    for (int e = 0; e < 16; ++e) S[e] = (((e & 3) + 8 * (e >> 2)) <= iq) ? S[e] : NEGBIG; }
#pragma unroll
                for (int s = 0; s < 4; ++s) S = __builtin_amdgcn_mfma_f32_32x32x16_bf16(kf[s], qf[x][s], S, 0, 0, 0);
                float mx = fmaxf(fmaxf(S[0], S[1]), fmaxf(S[2], S[3]));
#pragma unroll
                for (int e = 4; e < 16; e += 4) mx = fmaxf(mx, fmaxf(fmaxf(S[e], S[e + 1]), fmaxf(S[e + 2], S[e + 3])));
                mx = xmax32(mx);
                if (first) { mrun[x] = mx;
#pragma unroll
                    for (int e = 0; e < 16; ++e) S[e] -= mx; }
                else if (__any(mx > THR)) { const float dl = fmaxf(mx, 0.f); mrun[x] += dl; const float al = __builtin_amdgcn_exp2f(-dl); lsum[x] *= al;
#pragma unroll
                    for (int e = 0; e < 16; ++e) { S[e] -= dl; O[x][0][e] *= al; O[x][1][e] *= al; } }
                float ps = 0.f;
#pragma unroll
                for (int e = 0; e < 16; ++e) { S[e] = __builtin_amdgcn_exp2f(S[e]); ps += S[e]; }
                lsum[x] += ps;
                u32x4 w0, w1;
                w0.x = cvtpk(S[0], S[1]); w0.y = cvtpk(S[2], S[3]); w0.z = cvtpk(S[4], S[5]); w0.w = cvtpk(S[6], S[7]);
                w1.x = cvtpk(S[8], S[9]); w1.y = cvtpk(S[10], S[11]); w1.z = cvtpk(S[12], S[13]); w1.w = cvtpk(S[14], S[15]);
                const bf16x8 p0 = __builtin_bit_cast(bf16x8, w0), p1 = __builtin_bit_cast(bf16x8, w1);
                O[x][0] = __builtin_amdgcn_mfma_f32_32x32x16_bf16(vf[0][0], p0, O[x][0], 0, 0, 0);
                O[x][0] = __builtin_amdgcn_mfma_f32_32x32x16_bf16(vf[0][1], p1, O[x][0], 0, 0, 0);
                O[x][1] = __builtin_amdgcn_mfma_f32_32x32x16_bf16(vf[1][0], p0, O[x][1], 0, 0, 0);
                O[x][1] = __builtin_amdgcn_mfma_f32_32x32x16_bf16(vf[1][1], p1, O[x][1], 0, 0, 0);
            }
        }
    }
    const int slast = ((kt1 - kt0) & 1) ^ s0;
    next.qload();
    typedef __attribute__((address_space(3))) unsigned char* lds_p;
    const int ch = lane & 7;
    if (MODE == 0) {
        const lds_p stg = (lds_p)wl + slast * 8192;
#pragma unroll
        for (int x = 0; x < NQ; ++x) {
            const float lt = xsum32(lsum[x]);
            const lds_p st = stg + x * 4096;
            const float inv = 1.f / lt;
#pragma unroll
            for (int blk = 0; blk < 2; ++blk)
#pragma unroll
                for (int rg = 0; rg < 4; ++rg) { u32x2 w; w.x = cvtpk(O[x][blk][4 * rg] * inv, O[x][blk][4 * rg + 1] * inv); w.y = cvtpk(O[x][blk][4 * rg + 2] * inv, O[x][blk][4 * rg + 3] * inv);
                    *(__attribute__((address_space(3))) u32x2*)(st + i * 128 + (((4 * blk + rg) ^ (i & 7)) * 16) + 8 * hi) = w; }
            out.lse[x] = mrun[x] + __builtin_amdgcn_logf(lt);
        }
        asm volatile("s_waitcnt lgkmcnt(0)" ::: "memory"); __builtin_amdgcn_wave_barrier();
#pragma unroll
        for (int x = 0; x < NQ; ++x)
#pragma unroll
            for (int p = 0; p < 4; ++p) out.v[x][p] = *(const __attribute__((address_space(3))) u32x4*)(stg + x * 4096 + (8 * p + kl8) * 128 + ((ch ^ kl8) * 16));
    } else {
        const lds_p stg = (lds_p)wl;
        asm volatile("s_waitcnt vmcnt(0)" ::: "memory"); __syncthreads();
        u32x4 pa16[4], pa4[4], pb16[4], pb4[4]; float la16, la4, lb16 = 0.f, lb4 = 0.f;
        const float* l16p = B.pl16 + (b * 8 + h) * SEQ; const float* l4p = B.pl4 + (b * 8 + h) * SEQ;
#pragma unroll
        for (int p = 0; p < 4; ++p) { const int tokr = b * SEQ + (u0 + 8 * p + kl8) * d + r;
            pa16[p] = *(const u32x4*)(B.po16 + (size_t)tokr * POPITCH + h * 64 + ch * 8); pa4[p] = *(const u32x4*)(B.po4 + (size_t)tokr * POPITCH + h * 64 + ch * 8); }
        { const int t = u0 + i; la16 = l16p[(t & 15) * (SEQ / 16) + (t >> 4)]; la4 = l4p[(t & 3) * (SEQ / 4) + (t >> 2)]; }
        if (NQ == 2) {
#pragma unroll
            for (int p = 0; p < 4; ++p) { const int tokr = b * SEQ + (u0 + 32 + 8 * p + kl8) * d + r;
                pb16[p] = *(const u32x4*)(B.po16 + (size_t)tokr * POPITCH + h * 64 + ch * 8); pb4[p] = *(const u32x4*)(B.po4 + (size_t)tokr * POPITCH + h * 64 + ch * 8); }
            const int t = u0 + 32 + i; lb16 = l16p[(t & 15) * (SEQ / 16) + (t >> 4)]; lb4 = l4p[(t & 3) * (SEQ / 4) + (t >> 2)]; }
#pragma unroll
        for (int x = 0; x < NQ; ++x) {
            const float lt = xsum32(lsum[x]);
            const lds_p st = stg + x * 4608;
            u32x4 p16[4], p4[4];
#pragma unroll
            for (int p = 0; p < 4; ++p) { p16[p] = x ? pb16[p] : pa16[p]; p4[p] = x ? pb4[p] : pa4[p]; }
            const float l16 = x ? lb16 : la16, l4 = x ? lb4 : la4;
            const float M = fmaxf(fmaxf(mrun[x], l16), l4);
            const float w1 = __builtin_amdgcn_exp2f(mrun[x] - M), w16 = __builtin_amdgcn_exp2f(l16 - M), w4 = __builtin_amdgcn_exp2f(l4 - M);
            const float den = 1.f / (w1 * lt + w16 + w4); const float inv = 1.f / lt;
#pragma unroll
            for (int blk = 0; blk < 2; ++blk)
#pragma unroll
                for (int rg = 0; rg < 4; ++rg) { u32x2 w; w.x = cvtpk(O[x][blk][4 * rg] * inv, O[x][blk][4 * rg + 1] * inv); w.y = cvtpk(O[x][blk][4 * rg + 2] * inv, O[x][blk][4 * rg + 3] * inv);
                    *(__attribute__((address_space(3))) u32x2*)(st + i * 144 + 64 * blk + 16 * rg + 8 * hi) = w; }
            if (hi == 0) *(__attribute__((address_space(3))) f32x4*)(stg + 9216 + x * 512 + i * 16) = (f32x4){w1 * lt * den, w16 * den, w4 * den, 0.f};
            asm volatile("s_waitcnt lgkmcnt(0)" ::: "memory"); __builtin_amdgcn_wave_barrier();
            float myss = 0.f;
#pragma unroll
            for (int p = 0; p < 4; ++p) { const int row = 8 * p + kl8; const int tokr = b * SEQ + (u0 + 32 * x + row) * d + r;
                const u32x4 ov = *(const __attribute__((address_space(3))) u32x4*)(st + row * 144 + ch * 16);
                const f32x4 av = *(const __attribute__((address_space(3))) f32x4*)(stg + 9216 + x * 512 + row * 16);
                const u32x4 a = p16[p], c4 = p4[p];
                const float o0 = av.x * bflo(ov.x) + av.y * bflo(a.x) + av.z * bflo(c4.x), o1 = av.x * bfhi(ov.x) + av.y * bfhi(a.x) + av.z * bfhi(c4.x);
                const float o2 = av.x * bflo(ov.y) + av.y * bflo(a.y) + av.z * bflo(c4.y), o3 = av.x * bfhi(ov.y) + av.y * bfhi(a.y) + av.z * bfhi(c4.y);
                const float o4 = av.x * bflo(ov.z) + av.y * bflo(a.z) + av.z * bflo(c4.z), o5 = av.x * bfhi(ov.z) + av.y * bfhi(a.z) + av.z * bfhi(c4.z);
                const float o6 = av.x * bflo(ov.w) + av.y * bflo(a.w) + av.z * bflo(c4.w), o7 = av.x * bfhi(ov.w) + av.y * bfhi(a.w) + av.z * bfhi(c4.w);
                float ss = (o0 * o0 + o1 * o1) + (o2 * o2 + o3 * o3) + (o4 * o4 + o5 * o5) + (o6 * o6 + o7 * o7);
                ss += __shfl_xor(ss, 1); ss += __shfl_xor(ss, 2); ss += __shfl_xor(ss, 4);
                u32x4 w; w.x = cvtpk(o0, o1); w.y = cvtpk(o2, o3); w.z = cvtpk(o4, o5); w.w = cvtpk(o6, o7);
                *(u32x4*)(B.mix + (size_t)tokr * DM + h * 64 + ch * 8) = w;
                myss = (ch == p) ? ss : myss; }
            if (ch < 4) B.sumsq[(b * 8 + h) * SEQ + u0 + 32 * x + 8 * ch + kl8] = myss;
        }
    }
    asm volatile("s_waitcnt lgkmcnt(0)" ::: "memory"); __builtin_amdgcn_wave_barrier();
    return slast ^ 1;
}

__device__ __forceinline__ void item(const Bufs& B, lds_cptr wl, unsigned wl_addr, int b, int s, int h, int wave, int lane) {
    const float slope2 = exp2f(-(float)(h + 1)) * LOG2E;
    QPre<1> Pa, Pb; QPre<2> Pc, Pd; Stash<1> Sa, Sb; Stash<2> Sc, Sd;
    prolog_dma(B, wl_addr, b, h, 16, 2 * wave, 32 * s, lane, 0); prolog_q<1>(B, b, h, 16, 2 * wave, 32 * s, lane, Pa);
    int s0 = 0;
    s0 = qgroup<1, 0>(B, wl, wl_addr, b, h, 16, 2 * wave, 32 * s, slope2, lane, Pa, s0, NoFlush{}, NextPro<1>{B, wl_addr, b, h, 16, 2 * wave + 1, 32 * s, lane, Pb}, Sa);
    s0 = qgroup<1, 0>(B, wl, wl_addr, b, h, 16, 2 * wave + 1, 32 * s, slope2, lane, Pb, s0, Flush<1>{B.po16, B.pl16, b, h, 16, 2 * wave, 32 * s, lane, Sa},
                      NextPro<2>{B, wl_addr, b, h, 4, wave >> 1, 128 * s + 64 * (wave & 1), lane, Pc}, Sb);
    s0 = qgroup<2, 0>(B, wl, wl_addr, b, h, 4, wave >> 1, 128 * s + 64 * (wave & 1), slope2, lane, Pc, s0, Flush<1>{B.po16, B.pl16, b, h, 16, 2 * wave + 1, 32 * s, lane, Sb},
                      NextPro<2>{B, wl_addr, b, h, 1, 0, 512 * s + 64 * wave, lane, Pd}, Sc);
    qgroup<2, 1>(B, wl, wl_addr, b, h, 1, 0, 512 * s + 64 * wave, slope2, lane, Pd, s0, Flush<2>{B.po4, B.pl4, b, h, 4, wave >> 1, 128 * s + 64 * (wave & 1), lane, Sc}, NoNext{}, Sd);
}
}

namespace hg {
using att::f32x16; using att::s16x4; using att::lds_cptr; using att::vtr; using att::cvtpk; using att::xsum32; using att::glds16;
typedef __attribute__((address_space(3))) unsigned short* lds_u16p;
__device__ __forceinline__ void item(const Ctx& F, int b, int h) {
    const bf16* proj = (const bf16*)(F.ws + WS_PROJ); bf16* mix = (bf16*)(F.ws + WS_MIX);
    const float* gamma = F.in[4]; const float* ghn = F.in[5];
    int lane = F.lane, tid = F.tid; const int wave = F.wave;
    asm volatile("" : "+v"(lane), "+v"(tid));
    LAS unsigned char* wl = F.lds + wave * 16384;
    const unsigned wl_addr = (unsigned)(uintptr_t)wl;
    LAS float* decay = (LAS float*)(F.lds + LDS_TAB);
    LAS float* gnl = (LAS float*)(F.lds + LDS_TAB + 2048);
    const int i = lane & 31, hi = lane >> 5, iq = i - 4 * hi;
    const float lb = 1.f / (1.f + __expf(gamma[512 + h * 64 + lane] - gamma[h * 64 + lane])), oml = 1.f - lb;
    if (wave == 0) gnl[lane] = ghn[h * 64 + lane];
    float Sf[8];
#pragma unroll
    for (int j = 0; j < 8; ++j) Sf[j] = 0.f;
    const int sv = tid >> 3, sko = tid & 7;
    const int ksw = (i >> 1) & 7;
    int raddr[4];
#pragma unroll
    for (int s = 0; s < 4; ++s) raddr[s] = i * 128 + (((2 * s + hi) ^ ksw) * 16);
    const int g16 = lane >> 4, i16 = lane & 15, kbit = (i16 >> 3) & 1, vrow = 4 * hi + (i16 >> 2), vcol = 2 * (g16 & 1) + ((i16 & 3) >> 1), vb8 = (i16 & 1) * 8;
    const int ta0 = vrow * 128 + (vcol + 4 * kbit) * 16 + vb8, ta1 = vrow * 128 + (vcol + 4 * (1 - kbit)) * 16 + vb8;
    const size_t rowB = (size_t)PPITCH * 2;
    const int kl8 = lane >> 3, sw = lane >> 4;
    const char* cb = (const char*)proj + ((size_t)b * SEQ + wave * 32 + kl8) * rowB + (size_t)h * 128;
    const int rs0 = ((lane & 7) ^ sw) * 16, rs1 = ((lane & 7) ^ (4 + sw)) * 16, vs0 = ((lane & 7) ^ ((sw & 1) << 2)) * 16;
    const size_t pstep = 8 * rowB, gstep = 256 * rowB;
#define HG_DMA_R(colbytes, grp_, region) do { const char* s_ = cb + (size_t)(grp_) * gstep + (colbytes); const unsigned lb_ = wl_addr + (region); \
        glds16(s_ + rs0, (unsigned)__builtin_amdgcn_readfirstlane(lb_)); glds16(s_ + pstep + rs1, (unsigned)__builtin_amdgcn_readfirstlane(lb_ + 1024u)); \
        glds16(s_ + 2 * pstep + rs0, (unsigned)__builtin_amdgcn_readfirstlane(lb_ + 2048u)); glds16(s_ + 3 * pstep + rs1, (unsigned)__builtin_amdgcn_readfirstlane(lb_ + 3072u)); } while (0)
#define HG_DMA_V(colbytes, grp_, region) do { const char* s_ = cb + (size_t)(grp_) * gstep + (colbytes) + vs0; const unsigned lb_ = wl_addr + (region); \
        glds16(s_, (unsigned)__builtin_amdgcn_readfirstlane(lb_)); glds16(s_ + pstep, (unsigned)__builtin_amdgcn_readfirstlane(lb_ + 1024u)); \
        glds16(s_ + 2 * pstep, (unsigned)__builtin_amdgcn_readfirstlane(lb_ + 2048u)); glds16(s_ + 3 * pstep, (unsigned)__builtin_amdgcn_readfirstlane(lb_ + 3072u)); } while (0)
    HG_DMA_R(C_HQ * 2, 0, 0u); HG_DMA_R(C_HF * 2, 0, 4096u); HG_DMA_V(C_HI * 2, 0, 12288u);
    for (int grp = 0; grp < 8; ++grp) {
        const int tok0 = b * SEQ + (grp * 8 + wave) * 32;
        if (grp == 0) asm volatile("s_waitcnt vmcnt(0)" ::: "memory"); else asm volatile("s_waitcnt vmcnt(8)" ::: "memory");
        {
            float E1 = 1.f;
            const int kc = lane >> 3, kw = (lane & 7) * 2;
#pragma unroll
            for (int tb = 0; tb < 4; ++tb) {
                float qv[8], fr[8];
#pragma unroll
                for (int j = 0; j < 8; ++j) { const int t = 8 * tb + j; const int rsw = (kc ^ ((t >> 1) & 7)) * 16 + kw;
                    qv[j] = bf2f(*(lds_u16p)(wl + t * 128 + rsw)); fr[j] = bf2f(*(lds_u16p)(wl + 4096 + t * 128 + rsw)); }
                float ff[8], ky[8], qs[8], ee[8];
#pragma unroll
                for (int j = 0; j < 8; ++j) { const float sg = __builtin_amdgcn_rcpf(1.f + __builtin_amdgcn_exp2f(-fr[j] * LOG2E));
                    ff[j] = lb + oml * sg; ky[j] = oml * (1.f - sg);
                    qs[j] = qv[j] * __builtin_amdgcn_rcpf(1.f + __builtin_amdgcn_exp2f(-qv[j] * LOG2E)); }
#pragma unroll
                for (int j = 0; j < 8; ++j) { E1 *= ff[j]; ee[j] = E1; }
#pragma unroll
                for (int j = 0; j < 8; ++j) { const int t = 8 * tb + j; const int rsw = (kc ^ ((t >> 1) & 7)) * 16 + kw;
                    const unsigned pk = cvtpk(qs[j] * ee[j], ky[j] * __builtin_amdgcn_rcpf(ee[j]));
                    *(lds_u16p)(wl + t * 128 + rsw) = (unsigned short)pk;
                    *(lds_u16p)(wl + 4096 + t * 128 + rsw) = (unsigned short)(pk >> 16); }
            }
            decay[wave * 64 + lane] = E1;
        }
        asm volatile("s_waitcnt lgkmcnt(0)" ::: "memory"); __builtin_amdgcn_wave_barrier();
        bf16x8 qfB[4];
        f32x16 oT[2];
        u32x4 gpre[4];
        {
            f32x16 AT;
#pragma unroll
            for (int e = 0; e < 16; ++e) AT[e] = 0.f;
#pragma unroll
            for (int s = 0; s < 4; ++s) { qfB[s] = *(const LAS bf16x8*)(wl + raddr[s]); const bf16x8 kfA = *(const LAS bf16x8*)(wl + 4096 + raddr[s]);
                AT = __builtin_amdgcn_mfma_f32_32x32x16_bf16(kfA, qfB[s], AT, 0, 0, 0); }
            asm volatile("s_waitcnt lgkmcnt(0)" ::: "memory");
            if (grp < 7) { HG_DMA_R(C_HQ * 2, grp + 1, 0u); asm volatile("s_waitcnt vmcnt(4)" ::: "memory"); } else asm volatile("s_waitcnt vmcnt(0)" ::: "memory");
#pragma unroll
            for (int e = 0; e < 16; ++e) AT[e] = (((e & 3) + 8 * (e >> 2)) <= iq) ? AT[e] : 0.f;
            u32x4 w0, w1;
            w0.x = cvtpk(AT[0], AT[1]); w0.y = cvtpk(AT[2], AT[3]); w0.z = cvtpk(AT[4], AT[5]); w0.w = cvtpk(AT[6], AT[7]);
            w1.x = cvtpk(AT[8], AT[9]); w1.y = cvtpk(AT[10], AT[11]); w1.z = cvtpk(AT[12], AT[13]); w1.w = cvtpk(AT[14], AT[15]);
            const bf16x8 p0 = __builtin_bit_cast(bf16x8, w0), p1 = __builtin_bit_cast(bf16x8, w1);
            bf16x8 vf[2][2], ef[2][2];
            const lds_cptr vs = (lds_cptr)(wl + 12288), es = (lds_cptr)(wl + 4096);
            const int swk = 2 * hi + kbit;
#pragma unroll
            for (int ks = 0; ks < 2; ++ks) {
                const s16x4 a0 = vtr(vs + ta0 + 2048 * ks), a1 = vtr(vs + ta0 + 2048 * ks + 1024), b0 = vtr(vs + ta1 + 2048 * ks), b1 = vtr(vs + ta1 + 2048 * ks + 1024);
                vf[0][ks] = (bf16x8){a0[0], a0[1], a0[2], a0[3], a1[0], a1[1], a1[2], a1[3]}; vf[1][ks] = (bf16x8){b0[0], b0[1], b0[2], b0[3], b1[0], b1[1], b1[2], b1[3]};
#pragma unroll
                for (int kb = 0; kb < 2; ++kb) {
                    const s16x4 c0 = vtr(es + 2048 * ks + vrow * 128 + (((4 * kb + vcol) ^ swk) * 16) + vb8);
                    const s16x4 c1 = vtr(es + 2048 * ks + 1024 + vrow * 128 + (((4 * kb + vcol) ^ (4 + swk)) * 16) + vb8);
                    ef[kb][ks] = (bf16x8){c0[0], c0[1], c0[2], c0[3], c1[0], c1[1], c1[2], c1[3]}; }
            }
#pragma unroll
            for (int vb = 0; vb < 2; ++vb) {
#pragma unroll
                for (int e = 0; e < 16; ++e) oT[vb][e] = 0.f;
                oT[vb] = __builtin_amdgcn_mfma_f32_32x32x16_bf16(vf[vb][0], p0, oT[vb], 0, 0, 0);
                oT[vb] = __builtin_amdgcn_mfma_f32_32x32x16_bf16(vf[vb][1], p1, oT[vb], 0, 0, 0); }
#pragma unroll
            for (int kb = 0; kb < 2; ++kb)
#pragma unroll
                for (int vb = 0; vb < 2; ++vb) {
                    f32x16 dS;
#pragma unroll
                    for (int e = 0; e < 16; ++e) dS[e] = 0.f;
                    dS = __builtin_amdgcn_mfma_f32_32x32x16_bf16(ef[kb][0], vf[vb][0], dS, 0, 0, 0);
                    dS = __builtin_amdgcn_mfma_f32_32x32x16_bf16(ef[kb][1], vf[vb][1], dS, 0, 0, 0);
                    const int v = 32 * vb + i;
#pragma unroll
                    for (int rg = 0; rg < 4; ++rg) { u32x2 w; w.x = cvtpk(dS[4 * rg], dS[4 * rg + 1]); w.y = cvtpk(dS[4 * rg + 2], dS[4 * rg + 3]);
                        *(LAS u32x2*)(wl + 8192 + vb * 4096 + i * 128 + (((4 * kb + rg) ^ (i & 7)) * 16) + 8 * hi) = w; }
                }
            if (grp < 7) HG_DMA_R(C_HF * 2, grp + 1, 4096u);
            { const bf16* grow = proj + (size_t)(tok0 + (lane >> 3)) * PPITCH + C_HG + h * 64 + 8 * (lane & 7);
#pragma unroll
              for (int p = 0; p < 4; ++p) gpre[p] = *(const u32x4*)(grow + (size_t)(8 * p) * PPITCH); }
        }
        __syncthreads();
#pragma unroll
        for (int c = 0; c < 8; ++c) {
            LAS u32x4* sp = (LAS u32x4*)(F.lds + c * 16384 + 8192 + (sv >> 5) * 4096 + (sv & 31) * 128 + ((sko ^ (sv & 7)) * 16));
            const u32x4 dv = *sp; const f32x4 d0 = *(const LAS f32x4*)(decay + c * 64 + 8 * sko), d1 = *(const LAS f32x4*)(decay + c * 64 + 8 * sko + 4);
            u32x4 o; o.x = cvtpk(Sf[0], Sf[1]); o.y = cvtpk(Sf[2], Sf[3]); o.z = cvtpk(Sf[4], Sf[5]); o.w = cvtpk(Sf[6], Sf[7]);
            *sp = o;
            Sf[0] = d0.x * (Sf[0] + bflo(dv.x)); Sf[1] = d0.y * (Sf[1] + bfhi(dv.x)); Sf[2] = d0.z * (Sf[2] + bflo(dv.y)); Sf[3] = d0.w * (Sf[3] + bfhi(dv.y));
            Sf[4] = d1.x * (Sf[4] + bflo(dv.z)); Sf[5] = d1.y * (Sf[5] + bfhi(dv.z)); Sf[6] = d1.z * (Sf[6] + bflo(dv.w)); Sf[7] = d1.w * (Sf[7] + bfhi(dv.w));
        }
        __syncthreads();
        {
            bf16x8 sf[2][4];
#pragma unroll
            for (int vb = 0; vb < 2; ++vb) { const int v = 32 * vb + i;
#pragma unroll
                for (int s = 0; s < 4; ++s) sf[vb][s] = *(const LAS bf16x8*)(wl + 8192 + vb * 4096 + i * 128 + (((2 * s + hi) ^ (i & 7)) * 16)); }
            asm volatile("s_waitcnt lgkmcnt(0)" ::: "memory");
#pragma unroll
            for (int vb = 0; vb < 2; ++vb)
#pragma unroll
                for (int s = 0; s < 4; ++s) oT[vb] = __builtin_amdgcn_mfma_f32_32x32x16_bf16(sf[vb][s], qfB[s], oT[vb], 0, 0, 0);
        }
        {
            float ss = 0.f;
#pragma unroll
            for (int vb = 0; vb < 2; ++vb)
#pragma unroll
                for (int e = 0; e < 16; ++e) ss += oT[vb][e] * oT[vb][e];
            ss = xsum32(ss);
            const float rstd = 1.f / sqrtf(ss * (1.f / 64.f) + EPS);
            LAS unsigned char* st = wl + 8192;
#pragma unroll
            for (int vb = 0; vb < 2; ++vb)
#pragma unroll
                for (int rg = 0; rg < 4; ++rg) { u32x2 w; w.x = cvtpk(oT[vb][4 * rg] * rstd, oT[vb][4 * rg + 1] * rstd); w.y = cvtpk(oT[vb][4 * rg + 2] * rstd, oT[vb][4 * rg + 3] * rstd);
                    *(LAS u32x2*)(st + i * 128 + (((4 * vb + rg) ^ (i & 7)) * 16) + 8 * hi) = w; }
            asm volatile("s_waitcnt lgkmcnt(0)" ::: "memory"); __builtin_amdgcn_wave_barrier();
            const int ch = lane & 7, r8 = lane >> 3;
            const f32x4 gw0 = *(const LAS f32x4*)(gnl + 8 * ch), gw1 = *(const LAS f32x4*)(gnl + 8 * ch + 4);
#pragma unroll
            for (int p = 0; p < 4; ++p) { const int row = 8 * p + r8; const u32x4 ov = *(const LAS u32x4*)(st + row * 128 + ((ch ^ (row & 7)) * 16)); const u32x4 gp = gpre[p];
                u32x4 w;
                w.x = cvtpk(bflo(ov.x) * gw0.x * pg8::silu_f(bflo(gp.x)), bfhi(ov.x) * gw0.y * pg8::silu_f(bfhi(gp.x)));
                w.y = cvtpk(bflo(ov.y) * gw0.z * pg8::silu_f(bflo(gp.y)), bfhi(ov.y) * gw0.w * pg8::silu_f(bfhi(gp.y)));
                w.z = cvtpk(bflo(ov.z) * gw1.x * pg8::silu_f(bflo(gp.z)), bfhi(ov.z) * gw1.y * pg8::silu_f(bfhi(gp.z)));
                w.w = cvtpk(bflo(ov.w) * gw1.z * pg8::silu_f(bflo(gp.w)), bfhi(ov.w) * gw1.w * pg8::silu_f(bfhi(gp.w)));
                *(u32x4*)(mix + (size_t)(tok0 + row) * DM + 512 + h * 64 + 8 * ch) = w; }
            asm volatile("s_waitcnt lgkmcnt(0)" ::: "memory"); __builtin_amdgcn_wave_barrier();
            if (grp < 7) HG_DMA_V(C_HI * 2, grp + 1, 12288u);
        }
    }
#undef HG_DMA_R
#undef HG_DMA_V
}
}

constexpr int CW_Q = 12288;
__device__ __forceinline__ void mixer_phase(const Ctx& F, int qoff) {
    att::Bufs B; B.proj = (const bf16*)(F.ws + WS_PROJ);
    unsigned char* scr = (unsigned char*)F.out;
    B.po16 = (bf16*)scr; B.po4 = (bf16*)(scr + 40 * MiB); B.pl16 = (float*)(scr + 80 * MiB); B.pl4 = (float*)(scr + 81 * MiB);
    B.mix = (bf16*)(F.ws + WS_MIX); B.sumsq = (float*)(F.ws + WS_SUMSQ);
    const att::lds_cptr wl = (att::lds_cptr)(F.lds + F.wave * 16384);
    const unsigned wl_addr = (unsigned)(uintptr_t)(F.lds + F.wave * 16384);
    unsigned* q = (unsigned*)(F.ws + WS_CTL) + CW_Q + qoff;
    volatile LAS unsigned* MISC = (volatile LAS unsigned*)(F.lds + LDS_MISC);
    for (;;) {
        __syncthreads();
        if (F.tid == 0) MISC[16] = __hip_atomic_fetch_add(q, 1u, __ATOMIC_RELAXED, __HIP_MEMORY_SCOPE_AGENT);
        __syncthreads();
        const int id = (int)__builtin_amdgcn_readfirstlane(MISC[16]);
        if (id >= 896) break;
        if (id < 128) { hg::item(F, id >> 3, id & 7); continue; }
        int a = -1, c = -1;
        if (id < 128 + 640) { const int g = (id - 128) / 5, rr = (id - 128) % 5; if (rr < 4) a = 4 * g + rr; else c = g; }
        else c = 128 + (id - 768);
        if (a >= 0) att::item(B, wl, wl_addr, (a & 127) >> 3, 3 - (a >> 7), a & 7, F.wave, F.lane);
        else {
            LAS float* scr = (LAS float*)(F.lds + F.wave * 16384);
            for (int j = 0; j < 4; ++j) { const int t0 = 64 * c + 8 * F.wave + 2 * j;
                moe_convert_pair(F, (t0 >> 9) * 768 + (t0 & 511), ((t0 + 1) >> 9) * 768 + ((t0 + 1) & 511), scr, F.lane); } }
    }
}

constexpr int RT_ROWB = 2064;
__device__ __forceinline__ void route_mfma(const Ctx& F, const bool probe = false) {
    const bf16* x2 = (const bf16*)(F.ws + WS_H); unsigned char* H = (unsigned char*)(F.ws + WS_MIX); const float* g2 = F.in[7]; const bf16* wrt = (const bf16*)(F.ws + WS_WRT);
    const float* bgrp = F.in[9]; const float* bexp = F.in[11];
    int* tokl = (int*)(F.ws + (probe ? WS_PROJ : WS_TOKL)); float* gatel = (float*)(F.ws + (probe ? WS_PROJ + 8 * MiB : WS_GATEL)); int* slot = (int*)(F.ws + (probe ? WS_PROJ + 16 * MiB : WS_SLOT));
    unsigned* ctl = (unsigned*)(F.ws + WS_CTL) + (probe ? 4096 : 0); const float* ss2 = (const float*)(F.ws + WS_SSP);
    LAS unsigned char* wl = F.lds;
    LAS int* hist = (LAS int*)(F.lds + LDS_TAB);
    LAS int* gbase = hist + 32;
    LAS int* sel_e = gbase + 32;
    LAS int* sel_r = sel_e + 256;
    LAS float* sel_g = (LAS float*)(sel_r + 256);
    const int lane = F.lane, col = lane & 15, kq = lane >> 4;
    LAS unsigned char* g2l = F.lds + 2 * 36 * RT_ROWB;
    if (F.tid < 128) { const f32x4 ga = *(const f32x4*)(g2 + 8 * F.tid), gb = *(const f32x4*)(g2 + 8 * F.tid + 4);
        u32x4 gp; gp.x = att::cvtpk(ga.x, ga.y); gp.y = att::cvtpk(ga.z, ga.w); gp.z = att::cvtpk(gb.x, gb.y); gp.w = att::cvtpk(gb.z, gb.w); *(LAS u32x4*)(g2l + 16 * F.tid) = gp; }
    u32x4 xpre[16]; float ssq = 0.f;
    if (F.vcu < NTOK / 128) { const int tok = F.vcu * 128 + F.wave * 16 + col; { float pv[16];
#pragma unroll
            for (int j = 0; j < 16; ++j) pv[j] = ss2[(size_t)j * NTOK + tok];
            ssq = (((pv[0] + pv[1]) + (pv[2] + pv[3])) + ((pv[4] + pv[5]) + (pv[6] + pv[7]))) + (((pv[8] + pv[9]) + (pv[10] + pv[11])) + ((pv[12] + pv[13]) + (pv[14] + pv[15]))); }
        const bf16* xr = x2 + (size_t)tok * DM + 8 * kq;
#pragma unroll
        for (int S = 0; S < 16; ++S) xpre[S] = *(const u32x4*)(xr + 32 * S); }
    { const u32x4* s = (const u32x4*)wrt; u32x4 tv[18];
#pragma unroll
      for (int j = 0; j < 18; ++j) tv[j] = s[F.tid + j * NTHR];
#pragma unroll
      for (int j = 0; j < 18; ++j) { const int i = F.tid + j * NTHR, row = i >> 7, c = i & 127; *(LAS u32x4*)(wl + row * RT_ROWB + c * 16) = tv[j]; } }
    for (int chunk = F.vcu; chunk < NTOK / 128; chunk += F.G) {
        if (F.tid < 32) hist[F.tid] = 0;
        __syncthreads();
        {
            const int tok0 = chunk * 128 + F.wave * 16, tok = tok0 + col;
            const float rstd = 1.f / sqrtf(ssq * (1.f / DM) + EPS);
            const bf16* xr = x2 + (size_t)tok * DM + 8 * kq; const LAS unsigned char* gr = g2l + 16 * kq; unsigned char* hr = H + (size_t)tok * DM + 8 * kq;
            const LAS unsigned char* w0 = wl + col * RT_ROWB + 16 * kq; const LAS unsigned char* w1 = wl + (16 + col) * RT_ROWB + 16 * kq; const LAS unsigned char* w2 = wl + (32 + (col & 3)) * RT_ROWB + 16 * kq;
            constexpr int LO = 36 * RT_ROWB;
            f32x4 a0 = {0.f, 0.f, 0.f, 0.f}, a1 = a0, a2 = a0;
            u32x4 xlate[16];
#pragma unroll
            for (int S = 0; S < 16; ++S) xlate[S] = *(const u32x4*)(xr + 32 * (16 + S));
#pragma unroll
            for (int S = 0; S < 16; ++S) {
                const u32x4 xv = xpre[S];
                const u32x4 gv = *(const LAS u32x4*)(gr + 64 * S);
                u32x2 hw; hw.x = pg8::pk4_fp8(bflo(xv.x) * bflo(gv.x) * rstd, bfhi(xv.x) * bfhi(gv.x) * rstd, bflo(xv.y) * bflo(gv.y) * rstd, bfhi(xv.y) * bfhi(gv.y) * rstd);
                hw.y = pg8::pk4_fp8(bflo(xv.z) * bflo(gv.z) * rstd, bfhi(xv.z) * bfhi(gv.z) * rstd, bflo(xv.w) * bflo(gv.w) * rstd, bfhi(xv.w) * bfhi(gv.w) * rstd);
                *(u32x2*)(hr + 32 * S) = hw;
                const bf16x8 av = __builtin_bit_cast(bf16x8, xv);
                const bf16x8 h0 = *(const LAS bf16x8*)(w0 + 64 * S), h1 = *(const LAS bf16x8*)(w1 + 64 * S), h2 = *(const LAS bf16x8*)(w2 + 64 * S);
                const bf16x8 l0 = *(const LAS bf16x8*)(w0 + LO + 64 * S), l1 = *(const LAS bf16x8*)(w1 + LO + 64 * S), l2 = *(const LAS bf16x8*)(w2 + LO + 64 * S);
                a0 = __builtin_amdgcn_mfma_f32_16x16x32_bf16(av, h0, a0, 0, 0, 0); a0 = __builtin_amdgcn_mfma_f32_16x16x32_bf16(av, l0, a0, 0, 0, 0);
                a1 = __builtin_amdgcn_mfma_f32_16x16x32_bf16(av, h1, a1, 0, 0, 0); a1 = __builtin_amdgcn_mfma_f32_16x16x32_bf16(av, l1, a1, 0, 0, 0);
                a2 = __builtin_amdgcn_mfma_f32_16x16x32_bf16(av, h2, a2, 0, 0, 0); a2 = __builtin_amdgcn_mfma_f32_16x16x32_bf16(av, l2, a2, 0, 0, 0);
            }
#pragma unroll
            for (int S = 16; S < 32; ++S) {
                const u32x4 xv = xlate[S - 16];
                const u32x4 gv = *(const LAS u32x4*)(gr + 64 * S);
                u32x2 hw; hw.x = pg8::pk4_fp8(bflo(xv.x) * bflo(gv.x) * rstd, bfhi(xv.x) * bfhi(gv.x) * rstd, bflo(xv.y) * bflo(gv.y) * rstd, bfhi(xv.y) * bfhi(gv.y) * rstd);
                hw.y = pg8::pk4_fp8(bflo(xv.z) * bflo(gv.z) * rstd, bfhi(xv.z) * bfhi(gv.z) * rstd, bflo(xv.w) * bflo(gv.w) * rstd, bfhi(xv.w) * bfhi(gv.w) * rstd);
                *(u32x2*)(hr + 32 * S) = hw;
                const bf16x8 av = __builtin_bit_cast(bf16x8, xv);
                const bf16x8 h0 = *(const LAS bf16x8*)(w0 + 64 * S), h1 = *(const LAS bf16x8*)(w1 + 64 * S), h2 = *(const LAS bf16x8*)(w2 + 64 * S);
                const bf16x8 l0 = *(const LAS bf16x8*)(w0 + LO + 64 * S), l1 = *(const LAS bf16x8*)(w1 + LO + 64 * S), l2 = *(const LAS bf16x8*)(w2 + LO + 64 * S);
                a0 = __builtin_amdgcn_mfma_f32_16x16x32_bf16(av, h0, a0, 0, 0, 0); a0 = __builtin_amdgcn_mfma_f32_16x16x32_bf16(av, l0, a0, 0, 0, 0);
                a1 = __builtin_amdgcn_mfma_f32_16x16x32_bf16(av, h1, a1, 0, 0, 0); a1 = __builtin_amdgcn_mfma_f32_16x16x32_bf16(av, l1, a1, 0, 0, 0);
                a2 = __builtin_amdgcn_mfma_f32_16x16x32_bf16(av, h2, a2, 0, 0, 0); a2 = __builtin_amdgcn_mfma_f32_16x16x32_bf16(av, l2, a2, 0, 0, 0);
            }
            { float rs[4];
#pragma unroll
              for (int e = 0; e < 4; ++e) rs[e] = __shfl(rstd, 4 * kq + e);
#pragma unroll
              for (int e = 0; e < 4; ++e) { a0[e] *= rs[e]; a1[e] *= rs[e]; a2[e] *= rs[e]; } }
            const int rowbase = lane & 48;
            const float bia0 = (col < 4) ? bgrp[col] : bexp[col - 4], bia1 = bexp[12 + col], bia2 = (col < 4) ? bexp[28 + col] : 0.f;
#pragma unroll
            for (int e = 0; e < 4; ++e) {
                const float x0 = a0[e] + bia0, x1 = a1[e] + bia1, x2v = a2[e] + bia2;
                const float l0 = __shfl(x0, rowbase), l1 = __shfl(x0, rowbase + 1), l2 = __shfl(x0, rowbase + 2), l3 = __shfl(x0, rowbase + 3);
                int gs = 0; float gm = l0; if (l1 > gm) { gm = l1; gs = 1; } if (l2 > gm) { gm = l2; gs = 2; } if (l3 > gm) { gm = l3; gs = 3; }
                const float wg = 1.f / (expf(l0 - gm) + expf(l1 - gm) + expf(l2 - gm) + expf(l3 - gm));
                int i0 = 0, i1 = -1; float v0 = -INFINITY, v1 = -INFINITY;
#pragma unroll
                for (int i = 0; i < 8; ++i) { const int c = 4 + 8 * gs + i, src = rowbase + (c & 15);
                    const float s0 = __shfl(x0, src), s1 = __shfl(x1, src), s2 = __shfl(x2v, src);
                    const float v = (c < 16) ? s0 : ((c < 32) ? s1 : s2);
                    if (v > v0) { v1 = v0; i1 = i0; v0 = v; i0 = i; } else if (v > v1) { v1 = v; i1 = i; } }
                const float p0 = 1.f / (1.f + expf(v1 - v0)), p1 = 1.f - p0;
                if (col == 0) { const int li = F.wave * 16 + 4 * kq + e, e0 = gs * 8 + i0, e1 = gs * 8 + i1;
                    sel_e[li * 2] = e0; sel_e[li * 2 + 1] = e1; sel_g[li * 2] = wg * p0; sel_g[li * 2 + 1] = wg * p1;
                    sel_r[li * 2] = atomicAdd((int*)&hist[e0], 1); sel_r[li * 2 + 1] = atomicAdd((int*)&hist[e1], 1); }
            }
        }
        __syncthreads();
        if (F.tid < 32) gbase[F.tid] = (int)atomicAdd(ctl + CW_CNT + 64 * F.tid, (unsigned)hist[F.tid]);
        __syncthreads();
        if (F.tid < 256) { const int li = F.tid >> 1, tok = chunk * 128 + li; const int e = sel_e[F.tid], pos = gbase[e] + sel_r[F.tid];
            tokl[e * LISTCAP + pos] = tok; gatel[e * LISTCAP + pos] = sel_g[F.tid]; slot[tok * 2 + (F.tid & 1)] = e * LISTCAP + pos; }
        if (chunk + F.G < NTOK / 128) { const int tok = (chunk + F.G) * 128 + F.wave * 16 + col; { float pv[16];
#pragma unroll
            for (int j = 0; j < 16; ++j) pv[j] = ss2[(size_t)j * NTOK + tok];
            ssq = (((pv[0] + pv[1]) + (pv[2] + pv[3])) + ((pv[4] + pv[5]) + (pv[6] + pv[7]))) + (((pv[8] + pv[9]) + (pv[10] + pv[11])) + ((pv[12] + pv[13]) + (pv[14] + pv[15]))); }
            const bf16* xr = x2 + (size_t)tok * DM + 8 * kq;
#pragma unroll
            for (int S = 0; S < 16; ++S) xpre[S] = *(const u32x4*)(xr + 32 * S); }
        __syncthreads();
    }
}

__device__ __forceinline__ int moe_tables(const Ctx& F) {
    LAS int* tab = (LAS int*)(F.lds + LDS_TAB); unsigned* ctl = (unsigned*)(F.ws + WS_CTL);
    __syncthreads();
    if (F.tid < 32) {
        const int e = F.tid, c = (int)__hip_atomic_load(ctl + CW_CNT + 64 * e, __ATOMIC_RELAXED, __HIP_MEMORY_SCOPE_AGENT);
        const int nt = (c + 255) >> 8; int ps = nt;
#pragma unroll
        for (int d = 1; d < 32; d <<= 1) { const int v = __shfl_up(ps, d); if (e >= d) ps += v; }
        const int start = ps - nt;
        tab[3 * MAXMT + e] = start * 256;
        if (e == 31) tab[3 * MAXMT + 32] = ps;
        for (int r = 0; r < nt; ++r) { const int mt = start + r; tab[3 * mt] = e; tab[3 * mt + 1] = e * LISTCAP + 256 * r; tab[3 * mt + 2] = (c - 256 * r) < 256 ? (c - 256 * r) : 256; }
    }
    __syncthreads();
    return tab[3 * MAXMT + 32];
}

__device__ __forceinline__ void final_phase(const Ctx& F, float* dst) {
    float* out = F.out; const unsigned char* Y = (const unsigned char*)(F.ws + WS_Y); const int* slot = (const int*)(F.ws + WS_SLOT); const float* gf = F.in[15];
    const LAS int* tab = (const LAS int*)(F.lds + LDS_TAB);
    const int gw = F.vcu * NWAVES + F.wave, NGW = F.G * NWAVES, lane = F.lane;
    f32x4 gv[4];
#pragma unroll
    for (int j = 0; j < 4; ++j) gv[j] = ((const f32x4*)gf)[lane + 64 * j];
    for (int tok = gw; tok < NTOK; tok += NGW) {
        const int s0 = slot[tok * 2], s1 = slot[tok * 2 + 1];
        const int r0 = tab[3 * MAXMT + (s0 >> 15)] + (s0 & (LISTCAP - 1)), r1 = tab[3 * MAXMT + (s1 >> 15)] + (s1 & (LISTCAP - 1));
        f32x4* xr = (f32x4*)(out + (size_t)tok * DM) + lane; const u32x2* x2r = (const u32x2*)((const bf16*)(F.ws + WS_H) + (size_t)tok * DM) + lane;
        const unsigned* y0 = (const unsigned*)(Y + (size_t)r0 * DM) + lane; const unsigned* y1 = (const unsigned*)(Y + (size_t)r1 * DM) + lane;
        f32x4 v[4]; float s = 0.f;
#pragma unroll
        for (int j = 0; j < 4; ++j) { const u32x2 xx = x2r[64 * j]; v[j] = (f32x4){bflo(xx.x), bfhi(xx.x), bflo(xx.y), bfhi(xx.y)}; const unsigned a = y0[64 * j], b = y1[64 * j];
            { const f32x2 a01 = __builtin_amdgcn_cvt_pk_f32_fp8((int)a, false), a23 = __builtin_amdgcn_cvt_pk_f32_fp8((int)a, true), b01 = __builtin_amdgcn_cvt_pk_f32_fp8((int)b, false), b23 = __builtin_amdgcn_cvt_pk_f32_fp8((int)b, true);
              v[j].x += (a01.x + b01.x) * 0.0625f; v[j].y += (a01.y + b01.y) * 0.0625f; v[j].z += (a23.x + b23.x) * 0.0625f; v[j].w += (a23.y + b23.y) * 0.0625f; }
            s += (v[j].x * v[j].x + v[j].y * v[j].y) + (v[j].z * v[j].z + v[j].w * v[j].w); }
        const float rstd = 1.f / sqrtf(wave_sum(s) * (1.f / DM) + EPS);
#pragma unroll
        for (int j = 0; j < 4; ++j) ((f32x4*)(dst + (size_t)tok * DM) + lane)[64 * j] = v[j] * rstd * gv[j];
    }
}

constexpr int NPHASE = 9;
struct Args { const float* in[16]; float* out; unsigned char* ws; int ph_lo, ph_hi; };
__global__ void __launch_bounds__(NTHR, 2) fwd(Args args) {
    extern __shared__ __attribute__((aligned(16))) unsigned char lds_raw[];
    Ctx F;
    F.lds = (LAS unsigned char*)lds_raw;
    F.tid = threadIdx.x; F.lane = F.tid & 63; F.wave = __builtin_amdgcn_readfirstlane(F.tid >> 6);
    F.G = gridDim.x; { const int bx = blockIdx.x; F.vcu = (F.G % 8 == 0) ? (bx % 8) * (F.G / 8) + bx / 8 : bx; }
#pragma unroll
    for (int i = 0; i < 16; ++i) F.in[i] = args.in[i];
    F.out = args.out; F.ws = args.ws;
    volatile LAS unsigned* MISC = (volatile LAS unsigned*)(F.lds + LDS_MISC);
    if (F.tid < 32) MISC[F.tid] = 0u;
    __syncthreads();
    unsigned* ctl = (unsigned*)(F.ws + WS_CTL);
#if MK_FUSED
    XcdBarrier bar = xcd_barrier_post(ctl + CW_BAR, MISC + 8);
#define GRID_BAR() xcd_barrier(bar)
#else
#define GRID_BAR() do {} while (0)
#endif
    const int lo = args.ph_lo, hi = args.ph_hi;
#define IN(k) (lo <= (k) && (k) < hi)
#define BOTH(k) (IN(k) && IN((k) + 1))
    LAS unsigned char* ring = F.lds;

    if (IN(0)) { p0_prologue(F); if (PROBE_DUP == 0) { GRID_BAR(); p0_prologue(F); } if (BOTH(0)) GRID_BAR(); }
    if (IN(1)) {
        pg8::PlainSched S; S.init(NTOK, NPROJ, DM, F.G, (int)blockIdx.x, F.ws + WS_WIN);
        pg8::EpiProj E{(bf16_t*)(F.ws + WS_PROJ), PPITCH, QSCALE, (const float*)(F.ws + WS_SUMSQ)};
        pg8::gemm_phase<pg8::EpiProj, pg8::PlainSched, true>(ring, F.ws + WS_H, DM, S, E);
        if (PROBE_DUP == 1) { GRID_BAR(); pg8::gemm_phase<pg8::EpiProj, pg8::PlainSched, true>(ring, F.ws + WS_H, DM, S, E); }
        if (BOTH(1)) GRID_BAR();
    }
    if (IN(2)) { mixer_phase(F, 0); if (PROBE_DUP == 2) { GRID_BAR(); mixer_phase(F, 1024); } if (BOTH(2)) GRID_BAR(); }
    if (IN(4)) {
        pg8::PlainSched S; S.init(NTOK, DM, DM, F.G, (int)blockIdx.x, F.ws + WS_WOUT);
        LAS float* rtab = (LAS float*)(F.lds + LDS_TAB);
        { const float* sumsq = (const float*)(F.ws + WS_SUMSQ);
          { const int ui = F.tid >> 8, r = F.tid & 255; pg8::Unit u;
            if (S.next(ui, u)) { const int tok = u.pm * 256 + r; const float* sp = sumsq + (size_t)(tok >> 11) * 8 * SEQ + (tok & (SEQ - 1));
                  const float a0 = sp[0] + sp[SEQ], a1 = sp[2 * SEQ] + sp[3 * SEQ], a2 = sp[4 * SEQ] + sp[5 * SEQ], a3 = sp[6 * SEQ] + sp[7 * SEQ];
                  rtab[256 * ui + r] = 1.f / sqrtf(((a0 + a1) + (a2 + a3)) * (1.f / 512.f) + EPS); } }
          __syncthreads(); }
        pg8::EpiRes E{(const bf16_t*)(F.ws + WS_H), (bf16_t*)(F.ws + WS_H), DM, (float*)(F.ws + WS_SSP), rtab};
                pg8::gemm_phase<pg8::EpiRes, pg8::PlainSched, true>(ring, F.ws + WS_MIX, DM, S, E);
        if (BOTH(4)) GRID_BAR();
    }
    if (IN(5)) { if (PROBE_DUP == 5) { route_mfma(F, true); GRID_BAR(); } route_mfma(F); if (BOTH(5)) GRID_BAR(); }
    if (IN(6)) {
        const int T = moe_tables(F);
        pg8::MoeSched<true> S; S.G = F.G; S.c = (int)blockIdx.x; S.T = T; S.K = DM / 2; S.tab = (const LAS int*)(F.lds + LDS_TAB); S.tokl = (const int*)(F.ws + WS_TOKL); S.W = (const char*)(F.ws + WS_WGU); S.wexp = (size_t)DM * DM;
        pg8::EpiGU E{(unsigned char*)(F.ws + WS_HID)};
        pg8::gemm_phase<pg8::EpiGU, pg8::MoeSched<true>, true, true>(ring, F.ws + WS_MIX, DM / 2, S, E);
        if (PROBE_DUP == 6) { GRID_BAR(); pg8::gemm_phase<pg8::EpiGU, pg8::MoeSched<true>, true, true>(ring, F.ws + WS_MIX, DM / 2, S, E); }
        {
            unsigned* q2 = (unsigned*)(F.ws + WS_CTL) + CW_Q + 128;
            for (;;) {
                __syncthreads();
                if (F.tid == 0) MISC[16] = __hip_atomic_fetch_add(q2, 1u, __ATOMIC_RELAXED, __HIP_MEMORY_SCOPE_AGENT);
                __syncthreads();
                const int id = (int)__builtin_amdgcn_readfirstlane(MISC[16]);
                if (id >= 256) break;
                LAS float* scr = (LAS float*)(F.lds + F.wave * 16384);
                for (int j = 0; j < 2; ++j) { const int t0 = 32 * id + 4 * F.wave + 2 * j;
                    moe_convert_pair(F, (t0 >> 8) * 768 + 512 + (t0 & 255), ((t0 + 1) >> 8) * 768 + 512 + ((t0 + 1) & 255), scr, F.lane); }
            }
        }
        if (BOTH(6)) GRID_BAR();
    }
    if (IN(7)) {
        const int T = moe_tables(F);
        pg8::MoeSched<false> S; S.G = F.G; S.c = (int)blockIdx.x; S.T = T; S.K = DEXP / 2; S.tab = (const LAS int*)(F.lds + LDS_TAB); S.tokl = nullptr; S.W = (const char*)(F.ws + WS_WD); S.wexp = (size_t)DM * DEXP;
        pg8::EpiDown E{(unsigned char*)(F.ws + WS_Y), (const float*)(F.ws + WS_GATEL)};
        pg8::gemm_phase<pg8::EpiDown, pg8::MoeSched<false>, true, true>(ring, F.ws + WS_HID, DEXP / 2, S, E);
        if (PROBE_DUP == 7) { GRID_BAR(); pg8::gemm_phase<pg8::EpiDown, pg8::MoeSched<false>, true, true>(ring, F.ws + WS_HID, DEXP / 2, S, E); }
        if (BOTH(7)) GRID_BAR();
    }
    if (IN(8)) { (void)moe_tables(F); if (PROBE_DUP == 8) { final_phase(F, (float*)(F.ws + WS_MIX)); GRID_BAR(); } final_phase(F, F.out); }
#undef IN
#undef BOTH
}

extern "C" void kernel_launch(void* const* d_in, const int* in_sizes, int n_in, void* d_out, int out_size, void* d_ws, size_t ws_size, hipStream_t stream) {
    static int grid = 0;
    if (grid == 0) {
        if (n_in != 16 || out_size != NTOK * DM || ws_size < WS_END) { fprintf(stderr, "kernel_launch: unexpected shapes (n_in %d out %d ws %zu)\n", n_in, out_size, ws_size); grid = -1; return; }
        int dev = 0, cus = 0, per_cu = 0;
        if (hipGetDevice(&dev) != hipSuccess || hipDeviceGetAttribute(&cus, hipDeviceAttributeMultiprocessorCount, dev) != hipSuccess) { grid = -1; return; }
        if (hipFuncSetAttribute((const void*)fwd, hipFuncAttributeMaxDynamicSharedMemorySize, LDS_BYTES) != hipSuccess) { fprintf(stderr, "kernel_launch: hipFuncSetAttribute failed\n"); grid = -1; return; }
        if (hipOccupancyMaxActiveBlocksPerMultiprocessor(&per_cu, (const void*)fwd, NTHR, LDS_BYTES) != hipSuccess || per_cu < 1) fprintf(stderr, "kernel_launch: occupancy query reports %d\n", per_cu);
        (void)hipGetLastError();
        grid = cus;
    }
    if (grid < 0) return;
    (void)hipMemsetAsync((char*)d_ws + WS_CTL, 0, CTL_ZERO_BYTES, stream);
    Args a{};
    for (int i = 0; i < 16; ++i) a.in[i] = (const float*)d_in[i];
    a.out = (float*)d_out; a.ws = (unsigned char*)d_ws;
#if MK_FUSED
    a.ph_lo = 0; a.ph_hi = NPHASE;
    hipLaunchKernelGGL(fwd, dim3(grid), dim3(NTHR), LDS_BYTES, stream, a);
#else
    for (int p = 0; p < NPHASE; ++p) { a.ph_lo = p; a.ph_hi = p + 1; hipLaunchKernelGGL(fwd, dim3(grid), dim3(NTHR), LDS_BYTES, stream, a); }
#endif
}
```
